# Optimizing an MI355X kernel written in HIP

```python
import math
import jax, jax.numpy as jnp
from jax import lax
import numpy as np

D_MODEL = 2048
BATCH = 2
SEQ = 8192
DEPTH = 4

N_A = DEPTH // 2
N_B = DEPTH - N_A
DIFF_HEADS = 16
DIFF_HEAD_DIM = D_MODEL // DIFF_HEADS // 2
DIFF_V_DIM = 2 * DIFF_HEAD_DIM
SB_HEADS = 16
SB_HEAD_DIM = D_MODEL // SB_HEADS
D_FF = -(-8 * D_MODEL // (3 * 256)) * 256
N_BUCKETS = 32
MAX_DISTANCE = 128
Q_BLOCK = 128
RMS_EPS = 1e-5

kernel_name = "yoco_diff_stickbreaking_trunk"


def rmsnorm(x, g):
    xf = x.astype(jnp.float32)
    y = xf * lax.rsqrt(jnp.mean(xf * xf, axis=-1, keepdims=True) + RMS_EPS)
    return (y * g.astype(jnp.float32)).astype(x.dtype)


def t5_bucket(rel):
    max_exact = N_BUCKETS // 2
    n = jnp.maximum(rel, 0)
    nf = jnp.maximum(n, 1).astype(jnp.float32)
    large = max_exact + (jnp.log(nf / max_exact) / math.log(MAX_DISTANCE / max_exact)
                         * (N_BUCKETS - max_exact)).astype(jnp.int32)
    large = jnp.minimum(large, N_BUCKETS - 1)
    return jnp.where(n < max_exact, n, large)


def lambda_init_fn(layer):
    return 0.8 - 0.6 * math.exp(-0.3 * layer)


def diff_attention(h, w_qkv, w_o, lq1, lk1, lq2, lk2, subln_g, rel_bias, lambda_init):
    B, S, _ = h.shape
    H, dh, dv = DIFF_HEADS, DIFF_HEAD_DIM, DIFF_V_DIM
    nb = S // Q_BLOCK
    qkv = h @ w_qkv
    q, k, v = jnp.split(qkv, 3, axis=-1)
    q = q.reshape(B, S, 2 * H, dh).transpose(0, 2, 1, 3) * (dh ** -0.5)
    k = k.reshape(B, S, 2 * H, dh).transpose(0, 2, 1, 3)
    v = v.reshape(B, S, H, dv).transpose(0, 2, 1, 3)
    lam = (jnp.exp(jnp.sum(lq1.astype(jnp.float32) * lk1.astype(jnp.float32)))
           - jnp.exp(jnp.sum(lq2.astype(jnp.float32) * lk2.astype(jnp.float32)))
           + lambda_init)
    k_pos = jnp.arange(S)
    qb = q.reshape(B, 2 * H, nb, Q_BLOCK, dh).transpose(2, 0, 1, 3, 4)

    def block(args):
        qi, i = args
        q_pos = i * Q_BLOCK + jnp.arange(Q_BLOCK)
        rel = q_pos[:, None] - k_pos[None, :]
        bias = jnp.transpose(rel_bias[t5_bucket(rel)], (2, 0, 1)).astype(jnp.float32)
        s = jnp.einsum('bhqd,bhkd->bhqk', qi, k).astype(jnp.float32)
        s = s.reshape(B, H, 2, Q_BLOCK, S) + bias[None, :, None]
        s = jnp.where(rel >= 0, s, -jnp.inf)
        p = jax.nn.softmax(s, axis=-1)
        a = p[:, :, 0] - lam * p[:, :, 1]
        return jnp.einsum('bhqk,bhkd->bhqd', a.astype(v.dtype), v)

    o = lax.map(block, (qb, jnp.arange(nb)))
    o = o.transpose(1, 2, 0, 3, 4).reshape(B, H, S, dv)
    o = rmsnorm(o, subln_g) * (1.0 - lambda_init)
    o = o.transpose(0, 2, 1, 3).reshape(B, S, H * dv)
    return o @ w_o


def shared_kv(h, kv_norm_g, w_kv):
    B, S, _ = h.shape
    kv = rmsnorm(h, kv_norm_g) @ w_kv
    k, v = jnp.split(kv, 2, axis=-1)
    k = k.reshape(B, S, SB_HEADS, SB_HEAD_DIM).transpose(0, 2, 1, 3)
    v = v.reshape(B, S, SB_HEADS, SB_HEAD_DIM).transpose(0, 2, 1, 3)
    return k, v


def stick_breaking(h, w_q, w_o, k, v):
    B, S, _ = h.shape
    H, dh = SB_HEADS, SB_HEAD_DIM
    nb = S // Q_BLOCK
    q = (h @ w_q).reshape(B, S, H, dh).transpose(0, 2, 1, 3) * (dh ** -0.5)
    qb = q.reshape(B, H, nb, Q_BLOCK, dh).transpose(2, 0, 1, 3, 4)
    k_pos = jnp.arange(S)

    def block(args):
        qi, i = args
        q_pos = i * Q_BLOCK + jnp.arange(Q_BLOCK)
        causal = k_pos[None, :] < q_pos[:, None]
        z = jnp.einsum('bhqd,bhkd->bhqk', qi, k).astype(jnp.float32)
        log_not = jnp.where(causal, jax.nn.log_sigmoid(-z), 0.0)
        after = lax.cumsum(log_not, axis=log_not.ndim - 1, reverse=True) - log_not
        a = jnp.where(causal, jnp.exp(jax.nn.log_sigmoid(z) + after), 0.0)
        return jnp.einsum('bhqk,bhkd->bhqd', a.astype(v.dtype), v)

    o = lax.map(block, (qb, jnp.arange(nb)))
    o = o.transpose(1, 0, 3, 2, 4).reshape(B, S, H * dh)
    return o @ w_o


def swiglu(h, w_gate, w_up, w_down):
    return (jax.nn.silu(h @ w_gate) * (h @ w_up)) @ w_down


def setup_inputs(seed: int = 0) -> dict:
    key = jax.random.key(seed)
    ks = jax.random.split(key, 20)
    D, F = D_MODEL, D_FF
    f32 = jnp.float32

    def w(k, shape, fan_in):
        return jax.random.normal(k, shape, f32) * (fan_in ** -0.5)

    def gain(k, shape):
        return 1.0 + 0.02 * jax.random.normal(k, shape, f32)

    return {
        "x": jax.random.normal(ks[0], (BATCH, SEQ, D), f32),
        "rel_bias": 0.5 * jax.random.normal(ks[1], (N_BUCKETS, DIFF_HEADS), f32),
        "attn_norm_g": gain(ks[2], (DEPTH, D)),
        "ffn_norm_g": gain(ks[3], (DEPTH, D)),
        "diff_w_qkv": w(ks[4], (N_A, D, 3 * D), D),
        "diff_w_o": w(ks[5], (N_A, D, D), D),
        "diff_lambda_q1": 0.1 * jax.random.normal(ks[6], (N_A, DIFF_HEAD_DIM), f32),
        "diff_lambda_k1": 0.1 * jax.random.normal(ks[7], (N_A, DIFF_HEAD_DIM), f32),
        "diff_lambda_q2": 0.1 * jax.random.normal(ks[8], (N_A, DIFF_HEAD_DIM), f32),
        "diff_lambda_k2": 0.1 * jax.random.normal(ks[9], (N_A, DIFF_HEAD_DIM), f32),
        "diff_subln_g": gain(ks[10], (N_A, DIFF_V_DIM)),
        "kv_norm_g": gain(ks[11], (D,)),
        "sb_w_kv": w(ks[12], (D, 2 * D), D),
        "sb_w_q": w(ks[13], (N_B, D, D), D),
        "sb_w_o": w(ks[14], (N_B, D, D), D),
        "ffn_w_gate": w(ks[15], (DEPTH, D, F), D),
        "ffn_w_up": w(ks[16], (DEPTH, D, F), D),
        "ffn_w_down": w(ks[17], (DEPTH, F, D), F),
        "final_norm_g": gain(ks[18], (D,)),
    }


def reference(x, rel_bias, attn_norm_g, ffn_norm_g, diff_w_qkv, diff_w_o,
              diff_lambda_q1, diff_lambda_k1, diff_lambda_q2, diff_lambda_k2,
              diff_subln_g, kv_norm_g, sb_w_kv, sb_w_q, sb_w_o,
              ffn_w_gate, ffn_w_up, ffn_w_down, final_norm_g):
    h = x
    k_sh = v_sh = None
    for l in range(DEPTH):
        if l == N_A:
            k_sh, v_sh = shared_kv(h, kv_norm_g, sb_w_kv)
        hn = rmsnorm(h, attn_norm_g[l])
        if l < N_A:
            mix = diff_attention(hn, diff_w_qkv[l], diff_w_o[l],
                                 diff_lambda_q1[l], diff_lambda_k1[l],
                                 diff_lambda_q2[l], diff_lambda_k2[l],
                                 diff_subln_g[l], rel_bias, lambda_init_fn(l))
        else:
            j = l - N_A
            mix = stick_breaking(hn, sb_w_q[j], sb_w_o[j], k_sh, v_sh)
        h = h + mix
        h = h + swiglu(rmsnorm(h, ffn_norm_g[l]), ffn_w_gate[l], ffn_w_up[l], ffn_w_down[l])
    return rmsnorm(h, final_norm_g)
```

```cpp
#include <hip/hip_runtime.h>
#include <hip/hip_cooperative_groups.h>
#include <cstdio>
#include <cstdint>
#include <cmath>
namespace cg = cooperative_groups;
namespace pg8 {
#define PG8_LAS __attribute__((address_space(3)))
typedef unsigned short bf16_t;
typedef short bf16x8 __attribute__((ext_vector_type(8)));
typedef float f32x4 __attribute__((ext_vector_type(4)));
typedef unsigned u32x4 __attribute__((ext_vector_type(4)));
constexpr int BM = 256, BK = 64, HALF = 128, HTB = HALF * BK * 2  , STAGE_BYTES = 8 * HTB, NXCD = 8, WGM = 8;

__host__ __device__ __forceinline__ int lds_byte(int r, int c) { const int st = (r >> 4) * 2 + (c >> 5), rr = r & 15, cc = c & 31, ob = rr * 64 + cc * 2; return st * 1024 + (ob ^ (((ob >> 9) & 1) << 5)); }
__host__ __device__ __forceinline__ void stage_rc(int b, int& R, int& C) { const int st = b / 1024, sb = b % 1024, swz = sb ^ (((sb >> 9) & 1) << 5); R = (st >> 1) * 16 + swz / 64; C = (st & 1) * 32 + (swz % 64) / 2; }
__host__ __device__ __forceinline__ int perm32(int rho) { const int n = rho >> 4, i = rho & 15; return 8 * (i >> 2) + 4 * n + (i & 3); }

struct Unit { int pm, pn; };
struct Gemm { const bf16_t* A; const bf16_t* Bt; int M, N, K; };

struct StaticOrder {
    int nM, nN, nwg, G, c;
    __host__ __device__ void init(int M, int N, int G_, int c_) { nM = M / BM; nN = N / BM; nwg = nM * nN; G = G_; c = c_; }
    __host__ __device__ bool next(int i, Unit& u) const {
        const long L = (long)i * G + c; if (L >= nwg) return false;
        int wgid = (int)L; { const int q = nwg / NXCD, r = nwg % NXCD, xcd = wgid % NXCD, off = wgid / NXCD; wgid = (xcd < r ? xcd * (q + 1) : r * (q + 1) + (xcd - r) * q) + off; }
        const int nig = WGM * nN, gid = wgid / nig, fm = gid * WGM, gsz = (nM - fm) < WGM ? (nM - fm) : WGM;
        u.pm = fm + ((wgid % nig) % gsz); u.pn = (wgid % nig) / gsz; return true;
    }
    __device__ __forceinline__ void a_ready(const Unit&) const {}
    __device__ __forceinline__ void done(const Unit&) const {}
};

__device__ __forceinline__ unsigned cvt_pk_bf16(float lo, float hi) { unsigned r; asm volatile("v_cvt_pk_bf16_f32 %0, %1, %2" : "=v"(r) : "v"(lo), "v"(hi)); return r; }
typedef float f32x2 __attribute__((ext_vector_type(2)));

typedef unsigned u32x2e __attribute__((ext_vector_type(2)));
struct EpiBf16 {
    static constexpr bool PERM = true, AFTER_DRAIN = false;
    bf16_t* O; int ldc; int split_cols; size_t split_stride; float scale0;
    __device__ __forceinline__ void operator()(const f32x4 (&acc)[2][2][4][2], const Unit& u, int wr, int wc, int fr, int fq) const {
        const int row0 = u.pm * BM + wr * 64 + fr; int colt = u.pn * BM; bf16_t* base = O;
        float sc = 1.f; if (split_cols) { const int t = colt / split_cols; base += (size_t)t * split_stride; colt -= t * split_cols; if (t == 0) sc = scale0; }
        const int col0 = colt + wc * 32 + 8 * fq;
#pragma unroll
        for (int ai = 0; ai < 2; ++ai)
#pragma unroll
            for (int m = 0; m < 4; ++m) { bf16_t* rowp = base + (size_t)(row0 + ai * HALF + m * 16) * ldc + col0;
#pragma unroll
                for (int bj = 0; bj < 2; ++bj) { f32x4 v0 = acc[ai][bj][m][0] * sc, v1 = acc[ai][bj][m][1] * sc;
                    u32x4 w; w.x = cvt_pk_bf16(v0[0], v0[1]); w.y = cvt_pk_bf16(v0[2], v0[3]); w.z = cvt_pk_bf16(v1[0], v1[1]); w.w = cvt_pk_bf16(v1[2], v1[3]);
                    *(u32x4*)(rowp + bj * HALF) = w; } }
    }
};
struct EpiRes {
    static constexpr bool PERM = false, AFTER_DRAIN = false;
    const float* base; float* out; int ldc;
    __device__ __forceinline__ void operator()(const f32x4 (&acc)[2][2][4][2], const Unit& u, int wr, int wc, int fr, int fq) const {
        const int col0 = u.pn * BM + wc * 32 + 4 * fq;
#pragma unroll
        for (int ai = 0; ai < 2; ++ai)
#pragma unroll
            for (int m = 0; m < 4; ++m) { const size_t off = (size_t)(u.pm * BM + ai * HALF + wr * 64 + m * 16 + fr) * ldc + col0;
#pragma unroll
                for (int bj = 0; bj < 2; ++bj)
#pragma unroll
                    for (int n = 0; n < 2; ++n) { const f32x4 bs = *(const f32x4*)(base + off + bj * HALF + n * 16); *(f32x4*)(out + off + bj * HALF + n * 16) = bs + acc[ai][bj][m][n]; } }
    }
};
struct EpiSwiGLU {
    static constexpr bool PERM = true, AFTER_DRAIN = false;
    bf16_t* O; int ldc;
    __device__ __forceinline__ static float silu_mul(float g, float u) { return g * u * __builtin_amdgcn_rcpf(1.0f + __builtin_amdgcn_exp2f(-1.4426950408889634f * g)); }
    __device__ __forceinline__ void operator()(const f32x4 (&acc)[2][2][4][2], const Unit& u, int wr, int wc, int fr, int fq) const {
        const int row0 = u.pm * BM + wr * 64 + fr; const int col0 = u.pn * HALF + wc * 32 + 8 * fq;
#pragma unroll
        for (int ai = 0; ai < 2; ++ai)
#pragma unroll
            for (int m = 0; m < 4; ++m) { bf16_t* rowp = O + (size_t)(row0 + ai * HALF + m * 16) * ldc + col0;
                const f32x4 g0 = acc[ai][0][m][0], g1 = acc[ai][0][m][1], u0 = acc[ai][1][m][0], u1 = acc[ai][1][m][1];
                u32x4 w; w.x = cvt_pk_bf16(silu_mul(g0[0], u0[0]), silu_mul(g0[1], u0[1])); w.y = cvt_pk_bf16(silu_mul(g0[2], u0[2]), silu_mul(g0[3], u0[3]));
                w.z = cvt_pk_bf16(silu_mul(g1[0], u1[0]), silu_mul(g1[1], u1[1])); w.w = cvt_pk_bf16(silu_mul(g1[2], u1[2]), silu_mul(g1[3], u1[3]));
                *(u32x4*)rowp = w; }
    }
};

template <class Epi, class Sched, bool ALIGN_EPI = false, bool SP2 = false>
__device__ __forceinline__ void gemm_phase(PG8_LAS unsigned char* lds, const Gemm g, const Sched& S, const Epi& E) {
    int tid_ = threadIdx.x; asm volatile("" : "+v"(tid_));
    const int tid = tid_, wid = __builtin_amdgcn_readfirstlane(tid >> 6), lane = tid & 63, wr = wid >> 2, wc = wid & 3, fr = lane & 15, fq = lane >> 4;
    const int K = g.K, nt = K / BK;
    unsigned voffA[2], voffB[2];
#pragma unroll
    for (int i = 0; i < 2; ++i) { int R, C; stage_rc(tid * 16 + i * 8192, R, C); const int Rb = Epi::PERM ? ((R & ~31) + perm32(R & 31)) : R;
        voffA[i] = (unsigned)(R * K + C) * 2u; voffB[i] = (unsigned)(Rb * K + C) * 2u; }
    const size_t kstep = (size_t)(BK * 2);
    const size_t hstep = (size_t)HALF * K * 2;
    const size_t tstep = 2 * hstep;
    const unsigned ldsw = (unsigned)wid * 1024u;
    const int aoff = lds_byte(wr * 64 + fr, fq * 8), boff = lds_byte(wc * 32 + fr, fq * 8);
#define PG8_SA(b, h) (((b) * 2 + (h)) * HTB)
#define PG8_SB(b, h) ((4 + (b) * 2 + (h)) * HTB)
#define PG8_STAGE(bufoff, gbase, voff) do { _Pragma("unroll") for (int _i = 0; _i < 2; ++_i) \
        __builtin_amdgcn_global_load_lds((const unsigned*)((const char*)(gbase) + (voff)[_i]), (PG8_LAS unsigned*)(lds + (bufoff) + ldsw + _i * 8192), 16, 0, 0); } while (0)
#define PG8_LDA(dst, b, h) do { _Pragma("unroll") for (int m = 0; m < 4; ++m) _Pragma("unroll") for (int k = 0; k < 2; ++k) dst[m][k] = *(const PG8_LAS bf16x8*)(lds + PG8_SA(b, h) + aoff + m * 2048 + k * 1024); } while (0)
#define PG8_LDB(dst, b, h) do { _Pragma("unroll") for (int n = 0; n < 2; ++n) _Pragma("unroll") for (int k = 0; k < 2; ++k) dst[n][k] = *(const PG8_LAS bf16x8*)(lds + PG8_SB(b, h) + boff + n * 2048 + k * 1024); } while (0)
#define PG8_MMA(ai, bj, At, Bt) do { __builtin_amdgcn_s_setprio(1); _Pragma("unroll") for (int m = 0; m < 4; ++m) _Pragma("unroll") for (int n = 0; n < 2; ++n) _Pragma("unroll") for (int k = 0; k < 2; ++k) \
        acc[ai][bj][m][n] = __builtin_amdgcn_mfma_f32_16x16x32_bf16(Bt[n][k], At[m][k], acc[ai][bj][m][n], 0, 0, 0); __builtin_amdgcn_s_setprio(0); } while (0)
#define PG8_WAIT_V(n) asm volatile("s_waitcnt vmcnt(" #n ")" ::: "memory")
#define PG8_WAIT_L(n) asm volatile("s_waitcnt lgkmcnt(" #n ")" ::: "memory")
#define PG8_BAR __builtin_amdgcn_s_barrier()
#define PG8_SCHED __builtin_amdgcn_sched_barrier(0)
    Unit cur, nxt; int ui = 0;
    if (!S.next(0, cur)) return;
    f32x4 acc[2][2][4][2];
#pragma unroll
    for (int a = 0; a < 2; ++a)
#pragma unroll
        for (int b = 0; b < 2; ++b)
#pragma unroll
            for (int m = 0; m < 4; ++m)
#pragma unroll
                for (int n = 0; n < 2; ++n) acc[a][b][m][n] = (f32x4){0.f, 0.f, 0.f, 0.f};
    bf16x8 At[4][2], B0[2][2], B1[2][2];
    const char* cA = (const char*)g.A + (size_t)cur.pm * tstep; const char* cB = (const char*)g.Bt + (size_t)cur.pn * tstep;
    S.a_ready(cur);
    if constexpr (SP2) {
        PG8_STAGE(PG8_SB(0, 0), cB, voffB); PG8_STAGE(PG8_SB(0, 1), cB + hstep, voffB); PG8_STAGE(PG8_SA(0, 0), cA, voffA); PG8_STAGE(PG8_SA(0, 1), cA + hstep, voffA);
        if (wr == 1) PG8_BAR;
        PG8_WAIT_V(2); PG8_BAR;
        PG8_STAGE(PG8_SB(1, 0), cB + kstep, voffB); PG8_STAGE(PG8_SA(1, 0), cA + kstep, voffA); PG8_STAGE(PG8_SB(1, 1), cB + hstep + kstep, voffB);
        PG8_WAIT_V(6); PG8_BAR;
    } else {
        PG8_STAGE(PG8_SB(0, 0), cB, voffB); PG8_STAGE(PG8_SA(0, 0), cA, voffA); PG8_STAGE(PG8_SB(0, 1), cB + hstep, voffB); PG8_STAGE(PG8_SA(0, 1), cA + hstep, voffA);
        if (wr == 1) PG8_BAR;
        PG8_WAIT_V(4); PG8_BAR;
        PG8_STAGE(PG8_SB(1, 0), cB + kstep, voffB); PG8_STAGE(PG8_SA(1, 0), cA + kstep, voffA); PG8_STAGE(PG8_SB(1, 1), cB + hstep + kstep, voffB);
        PG8_WAIT_V(6); PG8_BAR;
    }
    for (;;) {
        const bool has_next = S.next(ui + 1, nxt);
        const char* nA = has_next ? (const char*)g.A + (size_t)nxt.pm * tstep : cA; const char* nB = has_next ? (const char*)g.Bt + (size_t)nxt.pn * tstep : cB;
        for (int t = 0; t < nt; t += 2) {
            const bool last = (t == nt - 2);
            const char* a1 = cA + (size_t)(t + 1) * kstep;
            const char* a2 = last ? nA : cA + (size_t)(t + 2) * kstep; const char* b2 = last ? nB : cB + (size_t)(t + 2) * kstep;
            const char* a3 = a2 + kstep; const char* b3 = b2 + kstep;
            if (last && has_next) S.a_ready(nxt);
            if constexpr (SP2) {
            PG8_LDB(B0, 0, 0); PG8_LDB(B1, 0, 1); PG8_SCHED; PG8_LDA(At, 0, 0); PG8_STAGE(PG8_SA(1, 1), a1 + hstep, voffA);
            PG8_WAIT_V(8); PG8_WAIT_L(0); PG8_BAR; PG8_MMA(0, 0, At, B0); PG8_MMA(0, 1, At, B1); PG8_BAR; PG8_SCHED;
            PG8_LDA(At, 0, 1); PG8_STAGE(PG8_SB(0, 0), b2, voffB); PG8_STAGE(PG8_SB(0, 1), b2 + hstep, voffB); PG8_STAGE(PG8_SA(0, 0), a2, voffA);
            PG8_WAIT_V(8); PG8_WAIT_L(0); PG8_BAR; PG8_MMA(1, 0, At, B0); PG8_MMA(1, 1, At, B1); PG8_BAR; PG8_SCHED;
            PG8_LDB(B0, 1, 0); PG8_LDB(B1, 1, 1); PG8_SCHED; PG8_LDA(At, 1, 0); PG8_STAGE(PG8_SA(0, 1), a2 + hstep, voffA);
            PG8_WAIT_V(8); PG8_WAIT_L(0); PG8_BAR; PG8_MMA(0, 0, At, B0); PG8_MMA(0, 1, At, B1); PG8_BAR; PG8_SCHED;
            PG8_LDA(At, 1, 1); PG8_STAGE(PG8_SB(1, 0), b3, voffB); PG8_STAGE(PG8_SB(1, 1), b3 + hstep, voffB); PG8_STAGE(PG8_SA(1, 0), a3, voffA);
            PG8_WAIT_V(8); PG8_WAIT_L(0); PG8_BAR; PG8_MMA(1, 0, At, B0); PG8_MMA(1, 1, At, B1); PG8_BAR; PG8_SCHED;
            } else {
            PG8_LDB(B0, 0, 0); PG8_SCHED; PG8_LDA(At, 0, 0); PG8_STAGE(PG8_SA(1, 1), a1 + hstep, voffA);
            PG8_WAIT_L(8); PG8_BAR; PG8_WAIT_L(0); PG8_MMA(0, 0, At, B0); PG8_BAR; PG8_SCHED;
            PG8_LDB(B1, 0, 1); PG8_STAGE(PG8_SB(0, 0), b2, voffB);
            PG8_BAR; PG8_WAIT_L(0); PG8_MMA(0, 1, At, B1); PG8_BAR;
            PG8_LDA(At, 0, 1); PG8_STAGE(PG8_SA(0, 0), a2, voffA);
            PG8_BAR; PG8_WAIT_L(0); PG8_MMA(1, 0, At, B0); PG8_BAR; PG8_SCHED;
            PG8_STAGE(PG8_SB(0, 1), b2 + hstep, voffB);
            PG8_WAIT_V(6); PG8_BAR; PG8_MMA(1, 1, At, B1); PG8_BAR;
            PG8_LDB(B0, 1, 0); PG8_SCHED; PG8_LDA(At, 1, 0); PG8_STAGE(PG8_SA(0, 1), a2 + hstep, voffA);
            PG8_WAIT_L(8); PG8_BAR; PG8_WAIT_L(0); PG8_MMA(0, 0, At, B0); PG8_BAR; PG8_SCHED;
            PG8_LDB(B1, 1, 1); PG8_STAGE(PG8_SB(1, 0), b3, voffB);
            PG8_BAR; PG8_WAIT_L(0); PG8_MMA(0, 1, At, B1); PG8_BAR;
            PG8_LDA(At, 1, 1); PG8_STAGE(PG8_SA(1, 0), a3, voffA);
            PG8_BAR; PG8_WAIT_L(0); PG8_MMA(1, 0, At, B0); PG8_BAR; PG8_SCHED;
            PG8_STAGE(PG8_SB(1, 1), b3 + hstep, voffB);
            PG8_WAIT_V(6); PG8_BAR; PG8_MMA(1, 1, At, B1); PG8_BAR;
            }
        }
        if constexpr (ALIGN_EPI) { if (wr == 0) PG8_BAR; }
        if constexpr (!Epi::AFTER_DRAIN) { E(acc, cur, wr, wc, fr, fq); S.done(cur); }
        if (!has_next) break;
#pragma unroll
        for (int a = 0; a < 2; ++a)
#pragma unroll
            for (int b = 0; b < 2; ++b)
#pragma unroll
                for (int m = 0; m < 4; ++m)
#pragma unroll
                    for (int n = 0; n < 2; ++n) acc[a][b][m][n] = (f32x4){0.f, 0.f, 0.f, 0.f};
        cur = nxt; cA = nA; cB = nB; ++ui;
        if constexpr (ALIGN_EPI) { if (wr == 1) PG8_BAR; }
    }
    PG8_WAIT_V(0);
    if constexpr (!ALIGN_EPI) { if (wr == 0) PG8_BAR; }
    PG8_BAR;
    if constexpr (Epi::AFTER_DRAIN) { E.fused(acc, cur, wr, wc, fr, fq, lds, wid, lane); S.done(cur); }
#undef PG8_SA
#undef PG8_SB
#undef PG8_STAGE
#undef PG8_LDA
#undef PG8_LDB
#undef PG8_MMA
#undef PG8_WAIT_V
#undef PG8_WAIT_L
#undef PG8_BAR
#undef PG8_SCHED
}
}

#define LAS __attribute__((address_space(3)))
typedef unsigned short bf16;
typedef short bf16x8 __attribute__((ext_vector_type(8)));
typedef float f32x4 __attribute__((ext_vector_type(4)));
typedef float f32x16 __attribute__((ext_vector_type(16)));
typedef unsigned u32x4 __attribute__((ext_vector_type(4)));
typedef unsigned u32x2 __attribute__((ext_vector_type(2)));

constexpr int NWAVES = 8, NTHREADS = 512;
constexpr int BATCH = 2, SEQ = 8192, DM = 2048, FF = 5632, MTOK = BATCH * SEQ;
constexpr float RMS_EPS = 1e-5f;
constexpr float LOG2E = 1.4426950408889634f, LN2 = 0.6931471805599453f;
constexpr int LDS_BYTES = 147456;

constexpr size_t MiB = 1u << 20;
constexpr size_t WS_WQKV = 2 * MiB;
constexpr size_t WS_WO   = WS_WQKV + 48 * MiB;
constexpr size_t WS_WKV  = WS_WO + 16 * MiB;
constexpr size_t WS_WSQ  = WS_WKV + 16 * MiB;
constexpr size_t WS_WSO  = WS_WSQ + 16 * MiB;
constexpr size_t WS_WGU  = WS_WSO + 16 * MiB;
constexpr size_t WS_WD   = WS_WGU + 176 * MiB;
constexpr size_t WS_XN   = WS_WD + 88 * MiB;
constexpr size_t WS_BIG  = WS_XN + 64 * MiB;
constexpr size_t WS_KS   = WS_BIG + 192 * MiB;
constexpr size_t WS_VTS  = WS_KS + 64 * MiB;
constexpr size_t WS_END  = WS_VTS + 64 * MiB;

__device__ __forceinline__ int fresh_tid() { int t = threadIdx.x; asm volatile("" : "+v"(t)); return t; }
__device__ __forceinline__ float wave_sum(float v) {
#pragma unroll
    for (int o = 1; o < 64; o <<= 1) v += __shfl_xor(v, o);
    return v;
}
__device__ __forceinline__ unsigned cvtpk(float lo, float hi) { unsigned r; asm volatile("v_cvt_pk_bf16_f32 %0, %1, %2" : "=v"(r) : "v"(lo), "v"(hi)); return r; }
__device__ __forceinline__ float swap32(float v) {
    auto rr = __builtin_amdgcn_permlane32_swap(__float_as_uint(v), __float_as_uint(v), false, false);
    return (threadIdx.x & 32) ? __uint_as_float(rr[0]) : __uint_as_float(rr[1]);
}

__device__ __forceinline__ void transpose_item(const float* W, int K, int N, bf16* WT, int mode, LAS float* scr, int item, int lane) {
    const int nblk = N / 32, kb = item / nblk, nb = item % nblk, k0 = 64 * kb, n0 = 32 * nb;
    int drow = n0;
    if (mode == 1) drow = 256 * (n0 >> 7) + (n0 & 127);
    if (mode == 2) drow = 256 * (n0 >> 7) + 128 + (n0 & 127);
#pragma unroll 8
    for (int i = 0; i < 32; ++i) { const int kk = 2 * i + (lane >> 5); scr[kk * 33 + (lane & 31)] = W[(size_t)(k0 + kk) * N + n0 + (lane & 31)]; }
    asm volatile("s_waitcnt lgkmcnt(0)" ::: "memory");
    const int c = lane & 7;
#pragma unroll
    for (int j = 0; j < 4; ++j) { const int n = (lane >> 3) + 8 * j; const LAS float* s = scr + (8 * c) * 33 + n;
        u32x4 o; o.x = cvtpk(s[0 * 33], s[1 * 33]); o.y = cvtpk(s[2 * 33], s[3 * 33]); o.z = cvtpk(s[4 * 33], s[5 * 33]); o.w = cvtpk(s[6 * 33], s[7 * 33]);
        *(u32x4*)(WT + (size_t)(drow + n) * K + k0 + 8 * c) = o; }
    asm volatile("s_waitcnt lgkmcnt(0)" ::: "memory");
}

__device__ __forceinline__ void norm_rows(const float* src, const float* g1, bf16* d1, const float* g2, bf16* d2, int gw, int ngw) {
    const int lane = fresh_tid() & 63;
    for (int m = gw; m < MTOK; m += ngw) {
        const f32x4* xr = (const f32x4*)(src + (size_t)m * DM) + lane;
        f32x4 v[8]; float s = 0.f;
#pragma unroll
        for (int j = 0; j < 8; ++j) { v[j] = xr[64 * j]; s += (v[j].x * v[j].x + v[j].y * v[j].y) + (v[j].z * v[j].z + v[j].w * v[j].w); }
        const float r = 1.0f / sqrtf(wave_sum(s) * (1.0f / DM) + RMS_EPS);
        u32x2* o1 = (u32x2*)(d1 + (size_t)m * DM) + lane;
#pragma unroll
        for (int j = 0; j < 8; ++j) { const f32x4 g = ((const f32x4*)g1)[lane + 64 * j]; u32x2 w; w.x = cvtpk(v[j].x * r * g.x, v[j].y * r * g.y); w.y = cvtpk(v[j].z * r * g.z, v[j].w * r * g.w); o1[64 * j] = w; }
        if (d2) { u32x2* o2 = (u32x2*)(d2 + (size_t)m * DM) + lane;
#pragma unroll
            for (int j = 0; j < 8; ++j) { const f32x4 g = ((const f32x4*)g2)[lane + 64 * j]; u32x2 w; w.x = cvtpk(v[j].x * r * g.x, v[j].y * r * g.y); w.y = cvtpk(v[j].z * r * g.z, v[j].w * r * g.w); o2[64 * j] = w; } }
    }
}
__device__ __forceinline__ void final_norm(float* io, const float* g1, int gw, int ngw) {
    const int lane = fresh_tid() & 63;
    for (int m = gw; m < MTOK; m += ngw) {
        f32x4* xr = (f32x4*)(io + (size_t)m * DM) + lane;
        f32x4 v[8]; float s = 0.f;
#pragma unroll
        for (int j = 0; j < 8; ++j) { v[j] = xr[64 * j]; s += (v[j].x * v[j].x + v[j].y * v[j].y) + (v[j].z * v[j].z + v[j].w * v[j].w); }
        const float r = 1.0f / sqrtf(wave_sum(s) * (1.0f / DM) + RMS_EPS);
#pragma unroll
        for (int j = 0; j < 8; ++j) { const f32x4 g = ((const f32x4*)g1)[lane + 64 * j]; xr[64 * j] = v[j] * r * g; }
    }
}

__device__ __forceinline__ int kperm(int r) { return (r & 0x13) | ((r & 4) << 1) | ((r & 8) >> 1); }
__device__ __forceinline__ int crow(int r, int hi) { return (r & 3) + 8 * (r >> 2) + 4 * hi; }

namespace dattn {
constexpr int KROW = 144, KT_BYTES = 64 * KROW, VT_BYTES = 128 * KROW, STAGE = 2 * KT_BYTES + VT_BYTES;
constexpr int LUT_OFF = 2 * STAGE;
constexpr int NUNITS = BATCH * 16 * 64;

__device__ __forceinline__ void unit(int b, int h, int qb, const bf16* __restrict__ Q, const bf16* __restrict__ K, const bf16* __restrict__ VT, bf16* __restrict__ O,
                                     LAS unsigned char* lds, float lam, const float* __restrict__ subg, float outscale) {
    int tid_ = threadIdx.x; asm volatile("" : "+v"(tid_));
    const int tid = tid_, lane = tid & 63, r32 = lane & 31, hi = lane >> 5;
    const int wid = __builtin_amdgcn_readfirstlane(tid >> 6), c = wid & 1, rg = wid >> 1;
    const int Q0 = qb * 128, qw = Q0 + 32 * rg, q = qw + r32;
    const int NT = Q0 / 64 + 2;
    const size_t tok0 = (size_t)b * SEQ;
    const LAS float* lut = (const LAS float*)(lds + LUT_OFF);
    bf16x8 qf[4];
    { const bf16* qp = Q + (tok0 + q) * DM + (2 * h + c) * 64 + 8 * hi;
#pragma unroll
      for (int ks = 0; ks < 4; ++ks) qf[ks] = *(const bf16x8*)(qp + 16 * ks); }
    const bf16* kg[2]; const bf16* vg[2]; int kl[2], vl[2];
#pragma unroll
    for (int i = 0; i < 2; ++i) {
        const int ck = tid + 512 * i, key = ck >> 4, part = ck & 15;
        kg[i] = K + (tok0 + key) * DM + (2 * h) * 64 + part * 8; kl[i] = (part >> 3) * KT_BYTES + key * KROW + (part & 7) * 16;
        const int d = ck >> 3, pv = ck & 7;
        vg[i] = VT + (size_t)(h * 128 + d) * MTOK + tok0 + pv * 8; vl[i] = 2 * KT_BYTES + d * KROW + pv * 16;
    }
    u32x4 kreg[2], vreg[2];
#define DA_LOAD(t) do { _Pragma("unroll") for (int i = 0; i < 2; ++i) { kreg[i] = *(const u32x4*)(kg[i] + (size_t)(t) * 64 * DM); vreg[i] = *(const u32x4*)(vg[i] + (t) * 64); } } while (0)
#define DA_STORE(st) do { _Pragma("unroll") for (int i = 0; i < 2; ++i) { *(LAS u32x4*)(lds + (st) * STAGE + kl[i]) = kreg[i]; *(LAS u32x4*)(lds + (st) * STAGE + vl[i]) = vreg[i]; } } while (0)
    f32x16 o[4];
#pragma unroll
    for (int i = 0; i < 4; ++i) o[i] = f32x16{};
    float m = -INFINITY, l = 0.f;
    DA_LOAD(0); DA_STORE(0);
    __syncthreads();
    const int koff = c * KT_BYTES + kperm(r32) * KROW + hi * 16;
    const int voff = 2 * KT_BYTES + r32 * KROW + hi * 16;
    for (int t = 0; t < NT; ++t) {
        const int k0 = 64 * t;
        if (t + 1 < NT) DA_LOAD(t + 1);
        if (k0 <= qw + 31) {
            const LAS unsigned char* st = lds + (t & 1) * STAGE;
            f32x16 p[2];
#pragma unroll
            for (int kb = 0; kb < 2; ++kb) {
                p[kb] = f32x16{};
#pragma unroll
                for (int ks = 0; ks < 4; ++ks) { const bf16x8 kf = *(const LAS bf16x8*)(st + koff + kb * 32 * KROW + ks * 32); p[kb] = __builtin_amdgcn_mfma_f32_32x32x16_bf16(kf, qf[ks], p[kb], 0, 0, 0); }
            }
            if (qw - (k0 + 63) < 128) {
#pragma unroll
                for (int kb = 0; kb < 2; ++kb)
#pragma unroll
                    for (int r = 0; r < 16; ++r) { const int key = k0 + 32 * kb + 16 * (r >> 3) + 8 * hi + (r & 7); const int rel = q - key;
                        const float bv = lut[rel < 0 ? 0 : (rel > 127 ? 127 : rel)]; p[kb][r] = rel < 0 ? -INFINITY : p[kb][r] + bv; }
            }
            float mx = p[0][0];
#pragma unroll
            for (int r = 1; r < 16; ++r) mx = fmaxf(mx, p[0][r]);
#pragma unroll
            for (int r = 0; r < 16; ++r) mx = fmaxf(mx, p[1][r]);
            mx = fmaxf(mx, swap32(mx));
            const float mnew = fmaxf(m, mx);
            if (__any(mnew > m)) {
                const float alpha = __builtin_amdgcn_exp2f(m - mnew);
#pragma unroll
                for (int i = 0; i < 4; ++i) o[i] *= alpha;
                l *= alpha; m = mnew;
            }
            float ls = 0.f;
#pragma unroll
            for (int kb = 0; kb < 2; ++kb)
#pragma unroll
                for (int r = 0; r < 16; ++r) { p[kb][r] = __builtin_amdgcn_exp2f(p[kb][r] - m); ls += p[kb][r]; }
            l += ls;
            bf16x8 pf[2][2];
#pragma unroll
            for (int kb = 0; kb < 2; ++kb)
#pragma unroll
                for (int s = 0; s < 2; ++s) { u32x4 w; w.x = cvtpk(p[kb][8 * s + 0], p[kb][8 * s + 1]); w.y = cvtpk(p[kb][8 * s + 2], p[kb][8 * s + 3]);
                    w.z = cvtpk(p[kb][8 * s + 4], p[kb][8 * s + 5]); w.w = cvtpk(p[kb][8 * s + 6], p[kb][8 * s + 7]); pf[kb][s] = __builtin_bit_cast(bf16x8, w); }
#pragma unroll
            for (int db = 0; db < 4; ++db)
#pragma unroll
                for (int kb = 0; kb < 2; ++kb)
#pragma unroll
                    for (int s = 0; s < 2; ++s) { const bf16x8 vf = *(const LAS bf16x8*)(st + voff + db * 32 * KROW + kb * 64 + s * 32); o[db] = __builtin_amdgcn_mfma_f32_32x32x16_bf16(vf, pf[kb][s], o[db], 0, 0, 0); }
        }
        if (t + 1 < NT) DA_STORE((t + 1) & 1);
        __syncthreads();
    }
#undef DA_LOAD
#undef DA_STORE
    l += swap32(l);
    const float inv = 1.0f / l;
    LAS float* comb = (LAS float*)lds;
    if (c == 1) {
#pragma unroll
        for (int db = 0; db < 4; ++db)
#pragma unroll
            for (int r = 0; r < 16; ++r) comb[((rg * 4 + db) * 16 + r) * 64 + lane] = o[db][r] * inv;
    }
    __syncthreads();
    if (c == 0) {
        float ss = 0.f;
#pragma unroll
        for (int db = 0; db < 4; ++db)
#pragma unroll
            for (int r = 0; r < 16; ++r) { const float y = o[db][r] * inv - lam * comb[((rg * 4 + db) * 16 + r) * 64 + lane]; o[db][r] = y; ss += y * y; }
        ss += swap32(ss);
        const float rs = outscale / sqrtf(ss * (1.0f / 128.0f) + RMS_EPS);
        bf16* op = O + (tok0 + q) * DM + h * 128 + 4 * hi;
#pragma unroll
        for (int db = 0; db < 4; ++db)
#pragma unroll
            for (int j = 0; j < 4; ++j) { const f32x4 g = *(const f32x4*)(subg + 32 * db + 8 * j + 4 * hi);
                u32x2 w; w.x = cvtpk(o[db][4 * j + 0] * rs * g.x, o[db][4 * j + 1] * rs * g.y); w.y = cvtpk(o[db][4 * j + 2] * rs * g.z, o[db][4 * j + 3] * rs * g.w);
                *(u32x2*)(op + 32 * db + 8 * j) = w; }
    }
    __syncthreads();
}
}

namespace sbattn {
constexpr int NUNITS = BATCH * 16 * 256;
__device__ __forceinline__ void unit(int b, int h, int qblk, const bf16* __restrict__ Q, const bf16* __restrict__ K, const bf16* __restrict__ VT, bf16* __restrict__ O) {
    int tid_ = threadIdx.x; asm volatile("" : "+v"(tid_));
    const int lane = tid_ & 63, r32 = lane & 31, hi = lane >> 5;
    const size_t tok0 = (size_t)b * SEQ;
    const int q = qblk * 32 + r32;
    bf16x8 qf[8];
    { const bf16* qp = Q + (tok0 + q) * DM + h * 128 + 8 * hi;
#pragma unroll
      for (int ks = 0; ks < 8; ++ks) qf[ks] = *(const bf16x8*)(qp + 16 * ks); }
    f32x16 o[4];
#pragma unroll
    for (int i = 0; i < 4; ++i) o[i] = f32x16{};
    float carry = 0.f;
    const bf16* kbase = K + (tok0 + kperm(r32)) * DM + h * 128 + 8 * hi;
    const bf16* vbase = VT + (size_t)(h * 128 + r32) * MTOK + tok0 + 8 * hi;
    for (int kt = qblk; kt >= 0; --kt) {
        const int k0 = kt * 32;
        f32x16 z = f32x16{};
        { const bf16* kp = kbase + (size_t)k0 * DM;
          bf16x8 kf[8];
#pragma unroll
          for (int ks = 0; ks < 8; ++ks) kf[ks] = *(const bf16x8*)(kp + 16 * ks);
#pragma unroll
          for (int ks = 0; ks < 8; ++ks) z = __builtin_amdgcn_mfma_f32_32x32x16_bf16(kf[ks], qf[ks], z, 0, 0, 0); }
        bf16x8 vf[4][2];
#pragma unroll
        for (int db = 0; db < 4; ++db)
#pragma unroll
            for (int s = 0; s < 2; ++s) vf[db][s] = *(const bf16x8*)(vbase + (size_t)(32 * db) * MTOK + k0 + 16 * s);
        float L[16], lz[16];
        float A0 = 0.f, A1 = 0.f;
#pragma unroll
        for (int r = 0; r < 16; ++r) {
            const int key = k0 + 16 * (r >> 3) + 8 * hi + (r & 7);
            const float zz = z[r];
            const float sp = fmaxf(zz, 0.f) + LN2 * __builtin_amdgcn_logf(1.0f + __builtin_amdgcn_exp2f(-LOG2E * fabsf(zz)));
            const bool valid = key < q;
            L[r] = valid ? -sp : 0.f;
            lz[r] = valid ? (zz - sp) : -INFINITY;
            if (r < 8) A0 += L[r]; else A1 += L[r];
        }
        const float B0 = swap32(A0), B1 = swap32(A1);
        const float base0 = hi ? (B1 + A1) : (B0 + A1 + B1);
        const float base1 = hi ? 0.f : B1;
        float a[16];
        { float run = base0 + carry;
#pragma unroll
          for (int i = 7; i >= 0; --i) { a[i] = __builtin_amdgcn_exp2f(LOG2E * (lz[i] + run)); run += L[i]; }
          run = base1 + carry;
#pragma unroll
          for (int i = 15; i >= 8; --i) { a[i] = __builtin_amdgcn_exp2f(LOG2E * (lz[i] + run)); run += L[i]; } }
        carry += (A0 + A1) + (B0 + B1);
        bf16x8 pf[2];
#pragma unroll
        for (int s = 0; s < 2; ++s) { u32x4 w; w.x = cvtpk(a[8 * s + 0], a[8 * s + 1]); w.y = cvtpk(a[8 * s + 2], a[8 * s + 3]); w.z = cvtpk(a[8 * s + 4], a[8 * s + 5]); w.w = cvtpk(a[8 * s + 6], a[8 * s + 7]); pf[s] = __builtin_bit_cast(bf16x8, w); }
#pragma unroll
        for (int db = 0; db < 4; ++db)
#pragma unroll
            for (int s = 0; s < 2; ++s) o[db] = __builtin_amdgcn_mfma_f32_32x32x16_bf16(vf[db][s], pf[s], o[db], 0, 0, 0);
        if (__all(carry < -105.0f)) break;
    }
    bf16* op = O + (tok0 + q) * DM + h * 128 + 4 * hi;
#pragma unroll
    for (int db = 0; db < 4; ++db)
#pragma unroll
        for (int j = 0; j < 4; ++j) { u32x2 w; w.x = cvtpk(o[db][4 * j + 0], o[db][4 * j + 1]); w.y = cvtpk(o[db][4 * j + 2], o[db][4 * j + 3]); *(u32x2*)(op + 32 * db + 8 * j) = w; }
}
}

struct Args {
    const float* x; const float* rel_bias; const float* attn_g; const float* ffn_g; const float* w_qkv; const float* w_o;
    const float* lq1; const float* lk1; const float* lq2; const float* lk2; const float* subln_g; const float* kv_g;
    const float* w_kv; const float* w_sq; const float* w_so; const float* w_gate; const float* w_up; const float* w_down; const float* final_g;
    float* out; unsigned char* ws;
};

__global__ void __launch_bounds__(NTHREADS, 2) yoco_fwd(Args a) {
    extern __shared__ __attribute__((aligned(16))) unsigned char lds_raw[];
    cg::grid_group grid = cg::this_grid();
    LAS unsigned char* lds = (LAS unsigned char*)lds_raw;
    const int wave = __builtin_amdgcn_readfirstlane(threadIdx.x >> 6);
    const int G = gridDim.x, bx = blockIdx.x;
    const int gw = bx * NWAVES + wave, ngw = G * NWAVES;
    unsigned char* ws = a.ws;
    bf16* Wqkv_t = (bf16*)(ws + WS_WQKV); bf16* Wo_t = (bf16*)(ws + WS_WO); bf16* Wkv_t = (bf16*)(ws + WS_WKV); bf16* Wsq_t = (bf16*)(ws + WS_WSQ); bf16* Wso_t = (bf16*)(ws + WS_WSO);
    bf16* Wgu_t = (bf16*)(ws + WS_WGU); bf16* Wd_t = (bf16*)(ws + WS_WD);
    bf16* XN = (bf16*)(ws + WS_XN); bf16* QB = (bf16*)(ws + WS_BIG); bf16* KB = QB + (size_t)MTOK * DM; bf16* VTB = KB + (size_t)MTOK * DM; bf16* MID = QB; bf16* XNKV = KB;
    bf16* KS = (bf16*)(ws + WS_KS); bf16* VTS = (bf16*)(ws + WS_VTS);

    {
        LAS float* scr = (LAS float*)(lds + wave * 16384);
        const int lane = fresh_tid() & 63;
        constexpr int I_QKV = 32 * 192, I_SQ = 32 * 64, I_KV = 32 * 128, I_G = 32 * 176, I_D = 88 * 64;
        constexpr int NITEMS = 2 * I_QKV + 2 * I_SQ + I_KV + 4 * I_SQ + 4 * (2 * I_G + I_D);
        for (int it = gw; it < NITEMS; it += ngw) {
            int r = it;
            if (r < 2 * I_QKV) { const int l = r / I_QKV; transpose_item(a.w_qkv + (size_t)l * DM * 6144, DM, 6144, Wqkv_t + (size_t)l * 6144 * DM, 0, scr, r % I_QKV, lane); continue; } r -= 2 * I_QKV;
            if (r < 2 * I_SQ) { const int l = r / I_SQ; transpose_item(a.w_o + (size_t)l * DM * DM, DM, DM, Wo_t + (size_t)l * DM * DM, 0, scr, r % I_SQ, lane); continue; } r -= 2 * I_SQ;
            if (r < I_KV) { transpose_item(a.w_kv, DM, 4096, Wkv_t, 0, scr, r, lane); continue; } r -= I_KV;
            if (r < 2 * I_SQ) { const int l = r / I_SQ; transpose_item(a.w_sq + (size_t)l * DM * DM, DM, DM, Wsq_t + (size_t)l * DM * DM, 0, scr, r % I_SQ, lane); continue; } r -= 2 * I_SQ;
            if (r < 2 * I_SQ) { const int l = r / I_SQ; transpose_item(a.w_so + (size_t)l * DM * DM, DM, DM, Wso_t + (size_t)l * DM * DM, 0, scr, r % I_SQ, lane); continue; } r -= 2 * I_SQ;
            if (r < 4 * I_G) { const int l = r / I_G; transpose_item(a.w_gate + (size_t)l * DM * FF, DM, FF, Wgu_t + (size_t)l * 2 * FF * DM, 1, scr, r % I_G, lane); continue; } r -= 4 * I_G;
            if (r < 4 * I_G) { const int l = r / I_G; transpose_item(a.w_up + (size_t)l * DM * FF, DM, FF, Wgu_t + (size_t)l * 2 * FF * DM, 2, scr, r % I_G, lane); continue; } r -= 4 * I_G;
            { const int l = r / I_D; transpose_item(a.w_down + (size_t)l * FF * DM, FF, DM, Wd_t + (size_t)l * DM * FF, 0, scr, r % I_D, lane); }
        }
        norm_rows(a.x, a.attn_g, XN, nullptr, nullptr, gw, ngw);
    }
    grid.sync();

    for (int l = 0; l < 4; ++l) {
        const bool diff = l < 2;
        const float* hsrc = (l == 0) ? a.x : a.out;
        if (l > 0) {
            if (l == 2) norm_rows(a.out, a.attn_g + l * DM, XN, a.kv_g, XNKV, gw, ngw);
            else norm_rows(a.out, a.attn_g + l * DM, XN, nullptr, nullptr, gw, ngw);
            grid.sync();
        }
        {
            pg8::Gemm g{XN, diff ? Wqkv_t + (size_t)l * 6144 * DM : Wsq_t + (size_t)(l - 2) * DM * DM, MTOK, diff ? 4096 : 2048, DM};
            pg8::StaticOrder S; S.init(g.M, g.N, G, bx);
            pg8::EpiBf16 E{QB, DM, 2048, (size_t)MTOK * DM, diff ? 0.125f * LOG2E : 0.08838834764831845f};
            pg8::gemm_phase<pg8::EpiBf16, pg8::StaticOrder, true, true>(lds, g, S, E);
        }
        if (diff || l == 2) {
            pg8::Gemm g{diff ? Wqkv_t + (size_t)l * 6144 * DM + (size_t)4096 * DM : Wkv_t + (size_t)2048 * DM, diff ? XN : XNKV, DM, MTOK, DM};
            pg8::StaticOrder S; S.init(g.M, g.N, G, bx);
            pg8::EpiBf16 E{diff ? VTB : VTS, MTOK, 0, 0, 1.f};
            pg8::gemm_phase<pg8::EpiBf16, pg8::StaticOrder, true, true>(lds, g, S, E);
        }
        if (l == 2) {
            pg8::Gemm g{XNKV, Wkv_t, MTOK, DM, DM};
            pg8::StaticOrder S; S.init(g.M, g.N, G, bx);
            pg8::EpiBf16 E{KS, DM, 0, 0, 1.f};
            pg8::gemm_phase<pg8::EpiBf16, pg8::StaticOrder, true, true>(lds, g, S, E);
        }
        grid.sync();
        if (diff) {
            const float lam_init = (l == 0) ? 0.2f : 0.35550906759f;
            float lam;
            const int tid = fresh_tid(), lane = tid & 63;
            { const float p1 = a.lq1[l * 64 + lane] * a.lk1[l * 64 + lane], p2 = a.lq2[l * 64 + lane] * a.lk2[l * 64 + lane];
              lam = expf(wave_sum(p1)) - expf(wave_sum(p2)) + lam_init; }
            int curh = -1;
            for (int i = 0;; ++i) {
                const int pos = i * G + ((i & 1) ? (G - 1 - bx) : bx);
                if (pos >= dattn::NUNITS) break;
                const int qb = 63 - pos / 32, bh = pos % 32, b = bh >> 4, h = bh & 15;
                if (h != curh) {
                    if (tid < 128) { const int n = tid; int bucket;
                        if (n < 16) bucket = n; else { int lg = 16 + (int)(logf((float)n / 16.0f) / 2.0794415416798357f * 16.0f); bucket = lg < 31 ? lg : 31; }
                        ((LAS float*)(lds + dattn::LUT_OFF))[n] = (a.rel_bias[bucket * 16 + h] - a.rel_bias[31 * 16 + h]) * LOG2E; }
                    curh = h;
                    __syncthreads();
                }
                dattn::unit(b, h, qb, QB, KB, VTB, XN, lds, lam, a.subln_g + l * 128, 1.0f - lam_init);
            }
        } else {
            for (int u = gw; u < sbattn::NUNITS; u += ngw) {
                const int bh = u >> 8, qblk = u & 255;
                sbattn::unit(bh >> 4, bh & 15, qblk, QB, KS, VTS, XN);
            }
        }
        grid.sync();
        {
            pg8::Gemm g{XN, diff ? Wo_t + (size_t)l * DM * DM : Wso_t + (size_t)(l - 2) * DM * DM, MTOK, DM, DM};
            pg8::StaticOrder S; S.init(g.M, g.N, G, bx);
            pg8::EpiRes E{hsrc, a.out, DM};
            pg8::gemm_phase<pg8::EpiRes, pg8::StaticOrder, true, true>(lds, g, S, E);
        }
        grid.sync();
        norm_rows(a.out, a.ffn_g + l * DM, XN, nullptr, nullptr, gw, ngw);
        grid.sync();
        {
            pg8::Gemm g{XN, Wgu_t + (size_t)l * 2 * FF * DM, MTOK, 2 * FF, DM};
            pg8::StaticOrder S; S.init(g.M, g.N, G, bx);
            pg8::EpiSwiGLU E{MID, FF};
            pg8::gemm_phase<pg8::EpiSwiGLU, pg8::StaticOrder, true, true>(lds, g, S, E);
        }
        grid.sync();
        {
            pg8::Gemm g{MID, Wd_t + (size_t)l * DM * FF, MTOK, DM, FF};
            pg8::StaticOrder S; S.init(g.M, g.N, G, bx);
            pg8::EpiRes E{a.out, a.out, DM};
            pg8::gemm_phase<pg8::EpiRes, pg8::StaticOrder, true, true>(lds, g, S, E);
        }
        grid.sync();
    }
    final_norm(a.out, a.final_g, gw, ngw);
}

extern "C" void kernel_launch(void* const* d_in, const int* in_sizes, int n_in, void* d_out, int out_size, void* d_ws, size_t ws_size, hipStream_t stream) {
    static int grid = 0;
    if (grid == 0) {
        if (n_in != 19 || ws_size < WS_END) { fprintf(stderr, "kernel_launch: unexpected inputs (%d) or workspace (%zu < %zu)\n", n_in, ws_size, (size_t)WS_END); grid = -1; return; }
        int dev = 0, cus = 0, per_cu = 0;
        hipGetDevice(&dev); hipDeviceGetAttribute(&cus, hipDeviceAttributeMultiprocessorCount, dev);
        hipFuncSetAttribute((const void*)yoco_fwd, hipFuncAttributeMaxDynamicSharedMemorySize, LDS_BYTES);
        hipOccupancyMaxActiveBlocksPerMultiprocessor(&per_cu, (const void*)yoco_fwd, NTHREADS, LDS_BYTES);
        (void)hipGetLastError();
        if (per_cu < 1) per_cu = 1;
        grid = cus * per_cu;
    }
    if (grid < 0) return;
    Args a{};
    a.x = (const float*)d_in[0]; a.rel_bias = (const float*)d_in[1]; a.attn_g = (const float*)d_in[2]; a.ffn_g = (const float*)d_in[3]; a.w_qkv = (const float*)d_in[4]; a.w_o = (const float*)d_in[5];
    a.lq1 = (const float*)d_in[6]; a.lk1 = (const float*)d_in[7]; a.lq2 = (const float*)d_in[8]; a.lk2 = (const float*)d_in[9]; a.subln_g = (const float*)d_in[10]; a.kv_g = (const float*)d_in[11];
    a.w_kv = (const float*)d_in[12]; a.w_sq = (const float*)d_in[13]; a.w_so = (const float*)d_in[14]; a.w_gate = (const float*)d_in[15]; a.w_up = (const float*)d_in[16]; a.w_down = (const float*)d_in[17]; a.final_g = (const float*)d_in[18];
    a.out = (float*)d_out; a.ws = (unsigned char*)d_ws;
    void* args[] = {&a};
    hipError_t e = hipLaunchCooperativeKernel((const void*)yoco_fwd, dim3(grid), dim3(NTHREADS), args, LDS_BYTES, stream);
    if (e != hipSuccess) fprintf(stderr, "cooperative launch failed: %s (grid %d)\n", hipGetErrorString(e), grid);
}
```

```cpp
#include <hip/hip_runtime.h>
#include <hip/hip_cooperative_groups.h>
#include <cstdio>
#include <cstdint>
#include <cmath>
namespace cg = cooperative_groups;
namespace pg8 {
#define PG8_LAS __attribute__((address_space(3)))
typedef unsigned short bf16_t;
typedef short bf16x8 __attribute__((ext_vector_type(8)));
typedef float f32x4 __attribute__((ext_vector_type(4)));
typedef unsigned u32x4 __attribute__((ext_vector_type(4)));
constexpr int BM = 256, BK = 64, HALF = 128, HTB = HALF * BK * 2  , STAGE_BYTES = 8 * HTB, NXCD = 8, WGM = 8;

__host__ __device__ __forceinline__ int lds_byte(int r, int c) { const int st = (r >> 4) * 2 + (c >> 5), rr = r & 15, cc = c & 31, ob = rr * 64 + cc * 2; return st * 1024 + (ob ^ (((ob >> 9) & 1) << 5)); }
__host__ __device__ __forceinline__ void stage_rc(int b, int& R, int& C) { const int st = b / 1024, sb = b % 1024, swz = sb ^ (((sb >> 9) & 1) << 5); R = (st >> 1) * 16 + swz / 64; C = (st & 1) * 32 + (swz % 64) / 2; }
__host__ __device__ __forceinline__ int perm32(int rho) { const int n = rho >> 4, i = rho & 15; return 8 * (i >> 2) + 4 * n + (i & 3); }

struct Unit { int pm, pn; };
struct Gemm { const bf16_t* A; const bf16_t* Bt; int M, N, K; };

struct StaticOrder {
    int nM, nN, nwg, G, c;
    __host__ __device__ void init(int M, int N, int G_, int c_) { nM = M / BM; nN = N / BM; nwg = nM * nN; G = G_; c = c_; }
    __host__ __device__ bool next(int i, Unit& u) const {
        const long L = (long)i * G + c; if (L >= nwg) return false;
        int wgid = (int)L; { const int q = nwg / NXCD, r = nwg % NXCD, xcd = wgid % NXCD, off = wgid / NXCD; wgid = (xcd < r ? xcd * (q + 1) : r * (q + 1) + (xcd - r) * q) + off; }
        const int nig = WGM * nN, gid = wgid / nig, fm = gid * WGM, gsz = (nM - fm) < WGM ? (nM - fm) : WGM;
        u.pm = fm + ((wgid % nig) % gsz); u.pn = (wgid % nig) / gsz; return true;
    }
    __device__ __forceinline__ void a_ready(const Unit&) const {}
    __device__ __forceinline__ void done(const Unit&) const {}
};

__device__ __forceinline__ unsigned cvt_pk_bf16(float lo, float hi) { unsigned r; asm volatile("v_cvt_pk_bf16_f32 %0, %1, %2" : "=v"(r) : "v"(lo), "v"(hi)); return r; }
typedef float f32x2 __attribute__((ext_vector_type(2)));

typedef unsigned u32x2e __attribute__((ext_vector_type(2)));
struct EpiBf16 {
    static constexpr bool PERM = true, AFTER_DRAIN = false;
    bf16_t* O; int ldc; int split_cols; size_t split_stride; float scale0;
    __device__ __forceinline__ void operator()(const f32x4 (&acc)[2][2][4][2], const Unit& u, int wr, int wc, int fr, int fq) const {
        const int row0 = u.pm * BM + wr * 64 + fr; int colt = u.pn * BM; bf16_t* base = O;
        float sc = 1.f; if (split_cols) { const int t = colt / split_cols; base += (size_t)t * split_stride; colt -= t * split_cols; if (t == 0) sc = scale0; }
        const int col0 = colt + wc * 32 + 8 * fq;
#pragma unroll
        for (int ai = 0; ai < 2; ++ai)
#pragma unroll
            for (int m = 0; m < 4; ++m) { bf16_t* rowp = base + (size_t)(row0 + ai * HALF + m * 16) * ldc + col0;
#pragma unroll
                for (int bj = 0; bj < 2; ++bj) { f32x4 v0 = acc[ai][bj][m][0] * sc, v1 = acc[ai][bj][m][1] * sc;
                    u32x4 w; w.x = cvt_pk_bf16(v0[0], v0[1]); w.y = cvt_pk_bf16(v0[2], v0[3]); w.z = cvt_pk_bf16(v1[0], v1[1]); w.w = cvt_pk_bf16(v1[2], v1[3]);
                    *(u32x4*)(rowp + bj * HALF) = w; } }
    }
};
struct EpiRes {
    static constexpr bool PERM = false, AFTER_DRAIN = false;
    const float* base; float* out; int ldc;
    __device__ __forceinline__ void operator()(const f32x4 (&acc)[2][2][4][2], const Unit& u, int wr, int wc, int fr, int fq) const {
        const int col0 = u.pn * BM + wc * 32 + 4 * fq;
#pragma unroll
        for (int ai = 0; ai < 2; ++ai)
#pragma unroll
            for (int m = 0; m < 4; ++m) { const size_t off = (size_t)(u.pm * BM + ai * HALF + wr * 64 + m * 16 + fr) * ldc + col0;
#pragma unroll
                for (int bj = 0; bj < 2; ++bj)
#pragma unroll
                    for (int n = 0; n < 2; ++n) { const f32x4 bs = *(const f32x4*)(base + off + bj * HALF + n * 16); *(f32x4*)(out + off + bj * HALF + n * 16) = bs + acc[ai][bj][m][n]; } }
    }
};
struct EpiSwiGLU {
    static constexpr bool PERM = true, AFTER_DRAIN = false;
    bf16_t* O; int ldc;
    __device__ __forceinline__ static float silu_mul(float g, float u) { return g * u * __builtin_amdgcn_rcpf(1.0f + __builtin_amdgcn_exp2f(-1.4426950408889634f * g)); }
    __device__ __forceinline__ void operator()(const f32x4 (&acc)[2][2][4][2], const Unit& u, int wr, int wc, int fr, int fq) const {
        const int row0 = u.pm * BM + wr * 64 + fr; const int col0 = u.pn * HALF + wc * 32 + 8 * fq;
#pragma unroll
        for (int ai = 0; ai < 2; ++ai)
#pragma unroll
            for (int m = 0; m < 4; ++m) { bf16_t* rowp = O + (size_t)(row0 + ai * HALF + m * 16) * ldc + col0;
                const f32x4 g0 = acc[ai][0][m][0], g1 = acc[ai][0][m][1], u0 = acc[ai][1][m][0], u1 = acc[ai][1][m][1];
                u32x4 w; w.x = cvt_pk_bf16(silu_mul(g0[0], u0[0]), silu_mul(g0[1], u0[1])); w.y = cvt_pk_bf16(silu_mul(g0[2], u0[2]), silu_mul(g0[3], u0[3]));
                w.z = cvt_pk_bf16(silu_mul(g1[0], u1[0]), silu_mul(g1[1], u1[1])); w.w = cvt_pk_bf16(silu_mul(g1[2], u1[2]), silu_mul(g1[3], u1[3]));
                *(u32x4*)rowp = w; }
    }
};

struct EpiVT {
    static constexpr bool PERM = true, AFTER_DRAIN = false;
    bf16_t* O;
    __device__ __forceinline__ void operator()(const f32x4 (&acc)[2][2][4][2], const Unit& u, int wr, int wc, int fr, int fq) const {
        const int row0 = u.pm * BM + wr * 64 + fr; const int col0 = u.pn * BM + wc * 32 + 8 * fq;
#pragma unroll
        for (int ai = 0; ai < 2; ++ai)
#pragma unroll
            for (int m = 0; m < 4; ++m) { const int ch = row0 + ai * HALF + m * 16;
#pragma unroll
                for (int bj = 0; bj < 2; ++bj) { const int col = col0 + bj * HALF; const f32x4 v0 = acc[ai][bj][m][0], v1 = acc[ai][bj][m][1];
                    u32x4 w; w.x = cvt_pk_bf16(v0[0], v0[1]); w.y = cvt_pk_bf16(v0[2], v0[3]); w.z = cvt_pk_bf16(v1[0], v1[1]); w.w = cvt_pk_bf16(v1[2], v1[3]);
                    *(u32x4*)(O + ((size_t)(col >> 6) * 2048 + ch) * 64 + (col & 63)) = w; } }
    }
};

template <class Epi, class Sched, bool ALIGN_EPI = false, bool SP2 = false>
__device__ __forceinline__ void gemm_phase(PG8_LAS unsigned char* lds, const Gemm g, const Sched& S, const Epi& E) {
    int tid_ = threadIdx.x; asm volatile("" : "+v"(tid_));
    const int tid = tid_, wid = __builtin_amdgcn_readfirstlane(tid >> 6), lane = tid & 63, wr = wid >> 2, wc = wid & 3, fr = lane & 15, fq = lane >> 4;
    const int K = g.K, nt = K / BK;
    unsigned voffA[2], voffB[2];
#pragma unroll
    for (int i = 0; i < 2; ++i) { int R, C; stage_rc(tid * 16 + i * 8192, R, C); const int Rb = Epi::PERM ? ((R & ~31) + perm32(R & 31)) : R;
        voffA[i] = (unsigned)(R * K + C) * 2u; voffB[i] = (unsigned)(Rb * K + C) * 2u; }
    const size_t kstep = (size_t)(BK * 2);
    const size_t hstep = (size_t)HALF * K * 2;
    const size_t tstep = 2 * hstep;
    const unsigned ldsw = (unsigned)wid * 1024u;
    const int aoff = lds_byte(wr * 64 + fr, fq * 8), boff = lds_byte(wc * 32 + fr, fq * 8);
#define PG8_SA(b, h) (((b) * 2 + (h)) * HTB)
#define PG8_SB(b, h) ((4 + (b) * 2 + (h)) * HTB)
#define PG8_STAGE(bufoff, gbase, voff) do { _Pragma("unroll") for (int _i = 0; _i < 2; ++_i) \
        __builtin_amdgcn_global_load_lds((const unsigned*)((const char*)(gbase) + (voff)[_i]), (PG8_LAS unsigned*)(lds + (bufoff) + ldsw + _i * 8192), 16, 0, 0); } while (0)
#define PG8_LDA(dst, b, h) do { _Pragma("unroll") for (int m = 0; m < 4; ++m) _Pragma("unroll") for (int k = 0; k < 2; ++k) dst[m][k] = *(const PG8_LAS bf16x8*)(lds + PG8_SA(b, h) + aoff + m * 2048 + k * 1024); } while (0)
#define PG8_LDB(dst, b, h) do { _Pragma("unroll") for (int n = 0; n < 2; ++n) _Pragma("unroll") for (int k = 0; k < 2; ++k) dst[n][k] = *(const PG8_LAS bf16x8*)(lds + PG8_SB(b, h) + boff + n * 2048 + k * 1024); } while (0)
#define PG8_MMA(ai, bj, At, Bt) do { __builtin_amdgcn_s_setprio(1); _Pragma("unroll") for (int m = 0; m < 4; ++m) _Pragma("unroll") for (int n = 0; n < 2; ++n) _Pragma("unroll") for (int k = 0; k < 2; ++k) \
        acc[ai][bj][m][n] = __builtin_amdgcn_mfma_f32_16x16x32_bf16(Bt[n][k], At[m][k], acc[ai][bj][m][n], 0, 0, 0); __builtin_amdgcn_s_setprio(0); } while (0)
#define PG8_WAIT_V(n) asm volatile("s_waitcnt vmcnt(" #n ")" ::: "memory")
#define PG8_WAIT_L(n) asm volatile("s_waitcnt lgkmcnt(" #n ")" ::: "memory")
#define PG8_BAR __builtin_amdgcn_s_barrier()
#define PG8_SCHED __builtin_amdgcn_sched_barrier(0)
    Unit cur, nxt; int ui = 0;
    if (!S.next(0, cur)) return;
    f32x4 acc[2][2][4][2];
#pragma unroll
    for (int a = 0; a < 2; ++a)
#pragma unroll
        for (int b = 0; b < 2; ++b)
#pragma unroll
            for (int m = 0; m < 4; ++m)
#pragma unroll
                for (int n = 0; n < 2; ++n) acc[a][b][m][n] = (f32x4){0.f, 0.f, 0.f, 0.f};
    bf16x8 At[4][2], B0[2][2], B1[2][2];
    const char* cA = (const char*)g.A + (size_t)cur.pm * tstep; const char* cB = (const char*)g.Bt + (size_t)cur.pn * tstep;
    S.a_ready(cur);
    if constexpr (SP2) {
        PG8_STAGE(PG8_SB(0, 0), cB, voffB); PG8_STAGE(PG8_SB(0, 1), cB + hstep, voffB); PG8_STAGE(PG8_SA(0, 0), cA, voffA); PG8_STAGE(PG8_SA(0, 1), cA + hstep, voffA);
        if (wr == 1) PG8_BAR;
        PG8_WAIT_V(2); PG8_BAR;
        PG8_STAGE(PG8_SB(1, 0), cB + kstep, voffB); PG8_STAGE(PG8_SA(1, 0), cA + kstep, voffA); PG8_STAGE(PG8_SB(1, 1), cB + hstep + kstep, voffB);
        PG8_WAIT_V(6); PG8_BAR;
    } else {
        PG8_STAGE(PG8_SB(0, 0), cB, voffB); PG8_STAGE(PG8_SA(0, 0), cA, voffA); PG8_STAGE(PG8_SB(0, 1), cB + hstep, voffB); PG8_STAGE(PG8_SA(0, 1), cA + hstep, voffA);
        if (wr == 1) PG8_BAR;
        PG8_WAIT_V(4); PG8_BAR;
        PG8_STAGE(PG8_SB(1, 0), cB + kstep, voffB); PG8_STAGE(PG8_SA(1, 0), cA + kstep, voffA); PG8_STAGE(PG8_SB(1, 1), cB + hstep + kstep, voffB);
        PG8_WAIT_V(6); PG8_BAR;
    }
    for (;;) {
        const bool has_next = S.next(ui + 1, nxt);
        const char* nA = has_next ? (const char*)g.A + (size_t)nxt.pm * tstep : cA; const char* nB = has_next ? (const char*)g.Bt + (size_t)nxt.pn * tstep : cB;
        for (int t = 0; t < nt; t += 2) {
            const bool last = (t == nt - 2);
            const char* a1 = cA + (size_t)(t + 1) * kstep;
            const char* a2 = last ? nA : cA + (size_t)(t + 2) * kstep; const char* b2 = last ? nB : cB + (size_t)(t + 2) * kstep;
            const char* a3 = a2 + kstep; const char* b3 = b2 + kstep;
            if (last && has_next) S.a_ready(nxt);
            if constexpr (SP2) {
            PG8_LDB(B0, 0, 0); PG8_LDB(B1, 0, 1); PG8_SCHED; PG8_LDA(At, 0, 0); PG8_STAGE(PG8_SA(1, 1), a1 + hstep, voffA);
            PG8_WAIT_V(8); PG8_WAIT_L(0); PG8_BAR; PG8_MMA(0, 0, At, B0); PG8_MMA(0, 1, At, B1); PG8_BAR; PG8_SCHED;
            PG8_LDA(At, 0, 1); PG8_STAGE(PG8_SB(0, 0), b2, voffB); PG8_STAGE(PG8_SB(0, 1), b2 + hstep, voffB); PG8_STAGE(PG8_SA(0, 0), a2, voffA);
            PG8_WAIT_V(8); PG8_WAIT_L(0); PG8_BAR; PG8_MMA(1, 0, At, B0); PG8_MMA(1, 1, At, B1); PG8_BAR; PG8_SCHED;
            PG8_LDB(B0, 1, 0); PG8_LDB(B1, 1, 1); PG8_SCHED; PG8_LDA(At, 1, 0); PG8_STAGE(PG8_SA(0, 1), a2 + hstep, voffA);
            PG8_WAIT_V(8); PG8_WAIT_L(0); PG8_BAR; PG8_MMA(0, 0, At, B0); PG8_MMA(0, 1, At, B1); PG8_BAR; PG8_SCHED;
            PG8_LDA(At, 1, 1); PG8_STAGE(PG8_SB(1, 0), b3, voffB); PG8_STAGE(PG8_SB(1, 1), b3 + hstep, voffB); PG8_STAGE(PG8_SA(1, 0), a3, voffA);
            PG8_WAIT_V(8); PG8_WAIT_L(0); PG8_BAR; PG8_MMA(1, 0, At, B0); PG8_MMA(1, 1, At, B1); PG8_BAR; PG8_SCHED;
            } else {
            PG8_LDB(B0, 0, 0); PG8_SCHED; PG8_LDA(At, 0, 0); PG8_STAGE(PG8_SA(1, 1), a1 + hstep, voffA);
            PG8_WAIT_L(8); PG8_BAR; PG8_WAIT_L(0); PG8_MMA(0, 0, At, B0); PG8_BAR; PG8_SCHED;
            PG8_LDB(B1, 0, 1); PG8_STAGE(PG8_SB(0, 0), b2, voffB);
            PG8_BAR; PG8_WAIT_L(0); PG8_MMA(0, 1, At, B1); PG8_BAR;
            PG8_LDA(At, 0, 1); PG8_STAGE(PG8_SA(0, 0), a2, voffA);
            PG8_BAR; PG8_WAIT_L(0); PG8_MMA(1, 0, At, B0); PG8_BAR; PG8_SCHED;
            PG8_STAGE(PG8_SB(0, 1), b2 + hstep, voffB);
            PG8_WAIT_V(6); PG8_BAR; PG8_MMA(1, 1, At, B1); PG8_BAR;
            PG8_LDB(B0, 1, 0); PG8_SCHED; PG8_LDA(At, 1, 0); PG8_STAGE(PG8_SA(0, 1), a2 + hstep, voffA);
            PG8_WAIT_L(8); PG8_BAR; PG8_WAIT_L(0); PG8_MMA(0, 0, At, B0); PG8_BAR; PG8_SCHED;
            PG8_LDB(B1, 1, 1); PG8_STAGE(PG8_SB(1, 0), b3, voffB);
            PG8_BAR; PG8_WAIT_L(0); PG8_MMA(0, 1, At, B1); PG8_BAR;
            PG8_LDA(At, 1, 1); PG8_STAGE(PG8_SA(1, 0), a3, voffA);
            PG8_BAR; PG8_WAIT_L(0); PG8_MMA(1, 0, At, B0); PG8_BAR; PG8_SCHED;
            PG8_STAGE(PG8_SB(1, 1), b3 + hstep, voffB);
            PG8_WAIT_V(6); PG8_BAR; PG8_MMA(1, 1, At, B1); PG8_BAR;
            }
        }
        if constexpr (ALIGN_EPI) { if (wr == 0) PG8_BAR; }
        if constexpr (!Epi::AFTER_DRAIN) { E(acc, cur, wr, wc, fr, fq); S.done(cur); }
        if (!has_next) break;
#pragma unroll
        for (int a = 0; a < 2; ++a)
#pragma unroll
            for (int b = 0; b < 2; ++b)
#pragma unroll
                for (int m = 0; m < 4; ++m)
#pragma unroll
                    for (int n = 0; n < 2; ++n) acc[a][b][m][n] = (f32x4){0.f, 0.f, 0.f, 0.f};
        cur = nxt; cA = nA; cB = nB; ++ui;
        if constexpr (ALIGN_EPI) { if (wr == 1) PG8_BAR; }
    }
    PG8_WAIT_V(0);
    if constexpr (!ALIGN_EPI) { if (wr == 0) PG8_BAR; }
    PG8_BAR;
    if constexpr (Epi::AFTER_DRAIN) { E.fused(acc, cur, wr, wc, fr, fq, lds, wid, lane); S.done(cur); }
#undef PG8_SA
#undef PG8_SB
#undef PG8_STAGE
#undef PG8_LDA
#undef PG8_LDB
#undef PG8_MMA
#undef PG8_WAIT_V
#undef PG8_WAIT_L
#undef PG8_BAR
#undef PG8_SCHED
}
}

#define LAS __attribute__((address_space(3)))
typedef unsigned short bf16;
typedef short bf16x8 __attribute__((ext_vector_type(8)));
typedef float f32x4 __attribute__((ext_vector_type(4)));
typedef float f32x16 __attribute__((ext_vector_type(16)));
typedef unsigned u32x4 __attribute__((ext_vector_type(4)));
typedef unsigned u32x2 __attribute__((ext_vector_type(2)));

constexpr int NWAVES = 8, NTHREADS = 512;
constexpr int BATCH = 2, SEQ = 8192, DM = 2048, FF = 5632, MTOK = BATCH * SEQ;
constexpr float RMS_EPS = 1e-5f;
constexpr float LOG2E = 1.4426950408889634f, LN2 = 0.6931471805599453f;
constexpr int LDS_BYTES = 147456;

constexpr size_t MiB = 1u << 20;
constexpr size_t WS_WQKV = 2 * MiB;
constexpr size_t WS_WO   = WS_WQKV + 48 * MiB;
constexpr size_t WS_WKV  = WS_WO + 16 * MiB;
constexpr size_t WS_WSQ  = WS_WKV + 16 * MiB;
constexpr size_t WS_WSO  = WS_WSQ + 16 * MiB;
constexpr size_t WS_WGU  = WS_WSO + 16 * MiB;
constexpr size_t WS_WD   = WS_WGU + 176 * MiB;
constexpr size_t WS_XN   = WS_WD + 88 * MiB;
constexpr size_t WS_BIG  = WS_XN + 64 * MiB;
constexpr size_t WS_KS   = WS_BIG + 192 * MiB;
constexpr size_t WS_VTS  = WS_KS + 64 * MiB;
constexpr size_t WS_END  = WS_VTS + 64 * MiB;

__device__ __forceinline__ int fresh_tid() { int t = threadIdx.x; asm volatile("" : "+v"(t)); return t; }
#define SWZ_XOR(v, k) __int_as_float(__builtin_amdgcn_ds_swizzle(__float_as_int(v), ((k) << 10) | 0x1f))
__device__ __forceinline__ float wave_sum(float v) {
    v += SWZ_XOR(v, 1); v += SWZ_XOR(v, 2); v += SWZ_XOR(v, 4); v += SWZ_XOR(v, 8); v += SWZ_XOR(v, 16);
    auto rr = __builtin_amdgcn_permlane32_swap(__float_as_uint(v), __float_as_uint(v), false, false);
    return __uint_as_float(rr[0]) + __uint_as_float(rr[1]);
}
__device__ __forceinline__ unsigned cvtpk(float lo, float hi) { unsigned r; asm volatile("v_cvt_pk_bf16_f32 %0, %1, %2" : "=v"(r) : "v"(lo), "v"(hi)); return r; }
__device__ __forceinline__ float swap32(float v) {
    auto rr = __builtin_amdgcn_permlane32_swap(__float_as_uint(v), __float_as_uint(v), false, false);
    return (threadIdx.x & 32) ? __uint_as_float(rr[0]) : __uint_as_float(rr[1]);
}

__device__ __forceinline__ void transpose_item(const float* W, int K, int N, bf16* WT, int mode, LAS float* scr, int item, int lane) {
    const int nblk = N / 32, kb = item / nblk, nb = item % nblk, k0 = 64 * kb, n0 = 32 * nb;
    int drow = n0;
    if (mode == 1) drow = 256 * (n0 >> 7) + (n0 & 127);
    if (mode == 2) drow = 256 * (n0 >> 7) + 128 + (n0 & 127);
#pragma unroll 8
    for (int i = 0; i < 32; ++i) { const int kk = 2 * i + (lane >> 5); scr[kk * 33 + (lane & 31)] = W[(size_t)(k0 + kk) * N + n0 + (lane & 31)]; }
    asm volatile("s_waitcnt lgkmcnt(0)" ::: "memory");
    const int c = lane & 7;
#pragma unroll
    for (int j = 0; j < 4; ++j) { const int n = (lane >> 3) + 8 * j; const LAS float* s = scr + (8 * c) * 33 + n;
        u32x4 o; o.x = cvtpk(s[0 * 33], s[1 * 33]); o.y = cvtpk(s[2 * 33], s[3 * 33]); o.z = cvtpk(s[4 * 33], s[5 * 33]); o.w = cvtpk(s[6 * 33], s[7 * 33]);
        *(u32x4*)(WT + (size_t)(drow + n) * K + k0 + 8 * c) = o; }
    asm volatile("s_waitcnt lgkmcnt(0)" ::: "memory");
}

__device__ __forceinline__ void norm_rows(const float* src, const float* g1, bf16* d1, const float* g2, bf16* d2, int gw, int ngw) {
    const int lane = fresh_tid() & 63;
    for (int m = gw; m < MTOK; m += ngw) {
        const f32x4* xr = (const f32x4*)(src + (size_t)m * DM) + lane;
        f32x4 v[8]; float s = 0.f;
#pragma unroll
        for (int j = 0; j < 8; ++j) { v[j] = xr[64 * j]; s += (v[j].x * v[j].x + v[j].y * v[j].y) + (v[j].z * v[j].z + v[j].w * v[j].w); }
        const float r = 1.0f / sqrtf(wave_sum(s) * (1.0f / DM) + RMS_EPS);
        u32x2* o1 = (u32x2*)(d1 + (size_t)m * DM) + lane;
#pragma unroll
        for (int j = 0; j < 8; ++j) { const f32x4 g = ((const f32x4*)g1)[lane + 64 * j]; u32x2 w; w.x = cvtpk(v[j].x * r * g.x, v[j].y * r * g.y); w.y = cvtpk(v[j].z * r * g.z, v[j].w * r * g.w); o1[64 * j] = w; }
        if (d2) { u32x2* o2 = (u32x2*)(d2 + (size_t)m * DM) + lane;
#pragma unroll
            for (int j = 0; j < 8; ++j) { const f32x4 g = ((const f32x4*)g2)[lane + 64 * j]; u32x2 w; w.x = cvtpk(v[j].x * r * g.x, v[j].y * r * g.y); w.y = cvtpk(v[j].z * r * g.z, v[j].w * r * g.w); o2[64 * j] = w; } }
    }
}
__device__ __forceinline__ void final_norm(float* io, const float* g1, int gw, int ngw) {
    const int lane = fresh_tid() & 63;
    for (int m = gw; m < MTOK; m += ngw) {
        f32x4* xr = (f32x4*)(io + (size_t)m * DM) + lane;
        f32x4 v[8]; float s = 0.f;
#pragma unroll
        for (int j = 0; j < 8; ++j) { v[j] = xr[64 * j]; s += (v[j].x * v[j].x + v[j].y * v[j].y) + (v[j].z * v[j].z + v[j].w * v[j].w); }
        const float r = 1.0f / sqrtf(wave_sum(s) * (1.0f / DM) + RMS_EPS);
#pragma unroll
        for (int j = 0; j < 8; ++j) { const f32x4 g = ((const f32x4*)g1)[lane + 64 * j]; xr[64 * j] = v[j] * r * g; }
    }
}

__device__ __forceinline__ int kperm(int r) { return (r & 0x13) | ((r & 4) << 1) | ((r & 8) >> 1); }
__device__ __forceinline__ int crow(int r, int hi) { return (r & 3) + 8 * (r >> 2) + 4 * hi; }

namespace dattn {
constexpr int NS = 4, STAGE = 32768, KSUB = 8192, VOFF = 16384;
constexpr int LUT_OFF = NS * STAGE;
constexpr int NUNITS = BATCH * 16 * 64;
#define DA_WAITV(n) asm volatile("s_waitcnt vmcnt(" #n ")" ::: "memory")

__device__ __forceinline__ void unit(int b, int h, int qb, const bf16* __restrict__ Q, const bf16* __restrict__ K, const bf16* __restrict__ VT, bf16* __restrict__ O,
                                     LAS unsigned char* lds, float lam, const float* __restrict__ subg, float outscale) {
    int tid_ = threadIdx.x; asm volatile("" : "+v"(tid_));
    const int tid = tid_, lane = tid & 63, r32 = lane & 31, hi = lane >> 5;
    const int wid = __builtin_amdgcn_readfirstlane(tid >> 6), c = wid & 1, rg = wid >> 1;
    const int Q0 = qb * 128, qw = Q0 + 32 * rg, q = qw + r32;
    const int NT = Q0 / 64 + 2;
    const size_t tok0 = (size_t)b * SEQ;
    const LAS float* lut = (const LAS float*)(lds + LUT_OFF);
    bf16x8 qf[4];
    { const bf16* qp = Q + (tok0 + q) * DM + (2 * h + c) * 64 + 8 * hi;
#pragma unroll
      for (int ks = 0; ks < 4; ++ks) qf[ks] = *(const bf16x8*)(qp + 16 * ks); }
    const int drow = 8 * wid + (lane >> 3), dch = (lane & 7) ^ ((drow >> 1) & 7);
    const int kgo = drow * DM + dch * 8, vgo = drow * 64 + dch * 8;
    const bf16* kgb = K + tok0 * DM + (2 * h) * 64;
    const bf16* vgb = VT + ((size_t)(b * 128) * 2048 + h * 128) * 64;
    const int dpiece = wid * 1024;
#define DA_DMA(t, st) do { const bf16* kb_ = kgb + (size_t)(t) * 64 * DM + kgo; const bf16* vb_ = vgb + (size_t)(t) * 2048 * 64 + vgo; LAS unsigned char* l_ = lds + (st) * STAGE + dpiece; \
        __builtin_amdgcn_global_load_lds((const unsigned*)kb_, (LAS unsigned*)l_, 16, 0, 0); \
        __builtin_amdgcn_global_load_lds((const unsigned*)(kb_ + 64), (LAS unsigned*)(l_ + KSUB), 16, 0, 0); \
        __builtin_amdgcn_global_load_lds((const unsigned*)vb_, (LAS unsigned*)(l_ + VOFF), 16, 0, 0); \
        __builtin_amdgcn_global_load_lds((const unsigned*)(vb_ + 64 * 64), (LAS unsigned*)(l_ + VOFF + 8192), 16, 0, 0); } while (0)
    DA_DMA(0, 0); DA_DMA(1, 1);
#pragma unroll
    for (int ks = 0; ks < 4; ++ks) asm volatile("" : "+v"(qf[ks]));
    f32x16 o[4];
#pragma unroll
    for (int i = 0; i < 4; ++i) o[i] = f32x16{};
    float m = -INFINITY, l = 0.f;
    int koffk[4], voffj[4];
    { const int kr = kperm(r32), swk = (kr >> 1) & 7, swv = (r32 >> 1) & 7;
#pragma unroll
      for (int i = 0; i < 4; ++i) { koffk[i] = c * KSUB + kr * 128 + (((2 * i + hi) ^ swk) << 4); voffj[i] = VOFF + r32 * 128 + (((2 * i + hi) ^ swv) << 4); } }
    const int grp = wid >> 2;
    bf16x8 pf[4];
#define DA_PV(tt) do { const LAS unsigned char* sv_ = lds + ((tt) & 3) * STAGE; bf16x8 va[8], vb[4], vc[4]; \
        _Pragma("unroll") for (int i = 0; i < 8; ++i) va[i] = *(const LAS bf16x8*)(sv_ + voffj[i >> 2] + (i & 3) * 4096); \
        _Pragma("unroll") for (int db = 0; db < 4; ++db) vb[db] = *(const LAS bf16x8*)(sv_ + voffj[2] + db * 4096); \
        __builtin_amdgcn_sched_barrier(0); \
        _Pragma("unroll") for (int db = 0; db < 4; ++db) o[db] = __builtin_amdgcn_mfma_f32_32x32x16_bf16(va[db], pf[0], o[db], 0, 0, 0); \
        __builtin_amdgcn_sched_barrier(0); \
        _Pragma("unroll") for (int db = 0; db < 4; ++db) vc[db] = *(const LAS bf16x8*)(sv_ + voffj[3] + db * 4096); \
        __builtin_amdgcn_sched_barrier(0); \
        _Pragma("unroll") for (int db = 0; db < 4; ++db) o[db] = __builtin_amdgcn_mfma_f32_32x32x16_bf16(va[4 + db], pf[1], o[db], 0, 0, 0); \
        _Pragma("unroll") for (int db = 0; db < 4; ++db) o[db] = __builtin_amdgcn_mfma_f32_32x32x16_bf16(vb[db], pf[2], o[db], 0, 0, 0); \
        _Pragma("unroll") for (int db = 0; db < 4; ++db) o[db] = __builtin_amdgcn_mfma_f32_32x32x16_bf16(vc[db], pf[3], o[db], 0, 0, 0); \
        __builtin_amdgcn_sched_barrier(0); } while (0)
    for (int t = 0; t <= NT; ++t) {
        const int k0 = 64 * t;
        DA_WAITV(4);
        __builtin_amdgcn_s_barrier();
        { int tn = t + 2; tn = tn < NT ? tn : NT - 1; DA_DMA(tn, (t + 2) & 3); }
        if (grp == 1 && t >= 1 && k0 - 64 <= qw + 31) DA_PV(t - 1);
        if (t < NT && k0 <= qw + 31) {
            const LAS unsigned char* st = lds + (t & 3) * STAGE;
            f32x16 p[2];
            {
                bf16x8 kf[8];
#pragma unroll
                for (int i = 0; i < 8; ++i) kf[i] = *(const LAS bf16x8*)(st + koffk[i & 3] + (i >> 2) * 4096);
                __builtin_amdgcn_sched_barrier(0);
                p[0] = __builtin_amdgcn_mfma_f32_32x32x16_bf16(kf[0], qf[0], f32x16{}, 0, 0, 0);
                p[1] = __builtin_amdgcn_mfma_f32_32x32x16_bf16(kf[4], qf[0], f32x16{}, 0, 0, 0);
#pragma unroll
                for (int ks = 1; ks < 4; ++ks) { p[0] = __builtin_amdgcn_mfma_f32_32x32x16_bf16(kf[ks], qf[ks], p[0], 0, 0, 0); p[1] = __builtin_amdgcn_mfma_f32_32x32x16_bf16(kf[4 + ks], qf[ks], p[1], 0, 0, 0); }
                __builtin_amdgcn_sched_barrier(0);
            }
            if (qw - (k0 + 63) < 128) {
#pragma unroll
                for (int kb = 0; kb < 2; ++kb)
#pragma unroll
                    for (int r = 0; r < 16; ++r) { const int key = k0 + 32 * kb + 16 * (r >> 3) + 8 * hi + (r & 7); const int rel = q - key;
                        p[kb][r] += lut[min(max(rel + 1, 0), 128)]; }
            }
            float mx = p[0][0];
#pragma unroll
            for (int r = 1; r < 16; ++r) mx = fmaxf(mx, p[0][r]);
#pragma unroll
            for (int r = 0; r < 16; ++r) mx = fmaxf(mx, p[1][r]);
            mx = fmaxf(mx, swap32(mx));
            if (__any(mx > m + 8.0f)) {
                const float mnew = fmaxf(m, mx);
                const float alpha = __builtin_amdgcn_exp2f(m - mnew);
#pragma unroll
                for (int i = 0; i < 4; ++i) o[i] *= alpha;
                l *= alpha; m = mnew;
            }
            float ls = 0.f;
#pragma unroll
            for (int kb = 0; kb < 2; ++kb)
#pragma unroll
                for (int r = 0; r < 16; ++r) { p[kb][r] = __builtin_amdgcn_exp2f(p[kb][r] - m); ls += p[kb][r]; }
            l += ls;
#pragma unroll
            for (int kb = 0; kb < 2; ++kb)
#pragma unroll
                for (int s = 0; s < 2; ++s) { u32x4 w; w.x = cvtpk(p[kb][8 * s + 0], p[kb][8 * s + 1]); w.y = cvtpk(p[kb][8 * s + 2], p[kb][8 * s + 3]);
                    w.z = cvtpk(p[kb][8 * s + 4], p[kb][8 * s + 5]); w.w = cvtpk(p[kb][8 * s + 6], p[kb][8 * s + 7]); pf[kb * 2 + s] = __builtin_bit_cast(bf16x8, w); }
            __builtin_amdgcn_sched_barrier(0);
            if (grp == 0) DA_PV(t);
        }
    }
#undef DA_PV
#undef DA_DMA
    DA_WAITV(0);
    __syncthreads();
    l += swap32(l);
    const float inv = 1.0f / l;
    LAS float* comb = (LAS float*)lds;
    if (c == 1) {
#pragma unroll
        for (int db = 0; db < 4; ++db)
#pragma unroll
            for (int r = 0; r < 16; ++r) comb[((rg * 4 + db) * 16 + r) * 64 + lane] = o[db][r] * inv;
    }
    __syncthreads();
    if (c == 0) {
        float ss = 0.f;
#pragma unroll
        for (int db = 0; db < 4; ++db)
#pragma unroll
            for (int r = 0; r < 16; ++r) { const float y = o[db][r] * inv - lam * comb[((rg * 4 + db) * 16 + r) * 64 + lane]; o[db][r] = y; ss += y * y; }
        ss += swap32(ss);
        const float rs = outscale / sqrtf(ss * (1.0f / 128.0f) + RMS_EPS);
        bf16* op = O + (tok0 + q) * DM + h * 128 + 4 * hi;
#pragma unroll
        for (int db = 0; db < 4; ++db)
#pragma unroll
            for (int j = 0; j < 4; ++j) { const f32x4 g = *(const f32x4*)(subg + 32 * db + 8 * j + 4 * hi);
                u32x2 w; w.x = cvtpk(o[db][4 * j + 0] * rs * g.x, o[db][4 * j + 1] * rs * g.y); w.y = cvtpk(o[db][4 * j + 2] * rs * g.z, o[db][4 * j + 3] * rs * g.w);
                *(u32x2*)(op + 32 * db + 8 * j) = w; }
    }
    __syncthreads();
}
}

namespace sbattn {
constexpr int NUNITS = BATCH * 16 * 256;
__device__ __forceinline__ void unit(int b, int h, int qblk, const bf16* __restrict__ Q, const bf16* __restrict__ K, const bf16* __restrict__ VT, bf16* __restrict__ O) {
    int tid_ = threadIdx.x; asm volatile("" : "+v"(tid_));
    const int lane = tid_ & 63, r32 = lane & 31, hi = lane >> 5;
    const size_t tok0 = (size_t)b * SEQ;
    const int q = qblk * 32 + r32;
    bf16x8 qf[8];
    { const bf16* qp = Q + (tok0 + q) * DM + h * 128 + 8 * hi;
#pragma unroll
      for (int ks = 0; ks < 8; ++ks) qf[ks] = *(const bf16x8*)(qp + 16 * ks);
#pragma unroll
      for (int ks = 0; ks < 8; ++ks) asm volatile("" : "+v"(qf[ks])); }
    f32x16 o[4];
#pragma unroll
    for (int i = 0; i < 4; ++i) o[i] = f32x16{};
    float carry = 0.f;
    const bf16* kbase = K + (tok0 + kperm(r32)) * DM + h * 128 + 8 * hi;
    const bf16* vbase = VT + ((size_t)(b * 128) * 2048 + h * 128 + r32) * 64 + 8 * hi;
    for (int kt = qblk; kt >= 0; --kt) {
        const int k0 = kt * 32;
        f32x16 z = f32x16{};
        { const bf16* kp = kbase + (size_t)k0 * DM;
          bf16x8 kf[8];
#pragma unroll
          for (int ks = 0; ks < 8; ++ks) kf[ks] = *(const bf16x8*)(kp + 16 * ks);
#pragma unroll
          for (int ks = 0; ks < 8; ++ks) z = __builtin_amdgcn_mfma_f32_32x32x16_bf16(kf[ks], qf[ks], z, 0, 0, 0); }
        bf16x8 vf[4][2];
#pragma unroll
        for (int db = 0; db < 4; ++db)
#pragma unroll
            for (int s = 0; s < 2; ++s) vf[db][s] = *(const bf16x8*)(vbase + ((size_t)(k0 >> 6) * 2048 + 32 * db) * 64 + (k0 & 63) + 16 * s);
        float L[16], lz[16];
        float A0 = 0.f, A1 = 0.f;
#pragma unroll
        for (int r = 0; r < 16; ++r) {
            const int key = k0 + 16 * (r >> 3) + 8 * hi + (r & 7);
            const float zz = z[r];
            const float sp = fmaxf(zz, 0.f) + LN2 * __builtin_amdgcn_logf(1.0f + __builtin_amdgcn_exp2f(-LOG2E * fabsf(zz)));
            const bool valid = key < q;
            L[r] = valid ? -sp : 0.f;
            lz[r] = valid ? (zz - sp) : -INFINITY;
            if (r < 8) A0 += L[r]; else A1 += L[r];
        }
        const float B0 = swap32(A0), B1 = swap32(A1);
        const float base0 = hi ? (B1 + A1) : (B0 + A1 + B1);
        const float base1 = hi ? 0.f : B1;
        float a[16];
        { float run = base0 + carry;
#pragma unroll
          for (int i = 7; i >= 0; --i) { a[i] = __builtin_amdgcn_exp2f(LOG2E * (lz[i] + run)); run += L[i]; }
          run = base1 + carry;
#pragma unroll
          for (int i = 15; i >= 8; --i) { a[i] = __builtin_amdgcn_exp2f(LOG2E * (lz[i] + run)); run += L[i]; } }
        carry += (A0 + A1) + (B0 + B1);
        bf16x8 pf[2];
#pragma unroll
        for (int s = 0; s < 2; ++s) { u32x4 w; w.x = cvtpk(a[8 * s + 0], a[8 * s + 1]); w.y = cvtpk(a[8 * s + 2], a[8 * s + 3]); w.z = cvtpk(a[8 * s + 4], a[8 * s + 5]); w.w = cvtpk(a[8 * s + 6], a[8 * s + 7]); pf[s] = __builtin_bit_cast(bf16x8, w); }
#pragma unroll
        for (int db = 0; db < 4; ++db)
#pragma unroll
            for (int s = 0; s < 2; ++s) o[db] = __builtin_amdgcn_mfma_f32_32x32x16_bf16(vf[db][s], pf[s], o[db], 0, 0, 0);
        if (__all(carry < -105.0f)) break;
    }
    bf16* op = O + (tok0 + q) * DM + h * 128 + 4 * hi;
#pragma unroll
    for (int db = 0; db < 4; ++db)
#pragma unroll
        for (int j = 0; j < 4; ++j) { u32x2 w; w.x = cvtpk(o[db][4 * j + 0], o[db][4 * j + 1]); w.y = cvtpk(o[db][4 * j + 2], o[db][4 * j + 3]); *(u32x2*)(op + 32 * db + 8 * j) = w; }
}
}

struct Args {
    const float* x; const float* rel_bias; const float* attn_g; const float* ffn_g; const float* w_qkv; const float* w_o;
    const float* lq1; const float* lk1; const float* lq2; const float* lk2; const float* subln_g; const float* kv_g;
    const float* w_kv; const float* w_sq; const float* w_so; const float* w_gate; const float* w_up; const float* w_down; const float* final_g;
    float* out; unsigned char* ws;
};

__global__ void __launch_bounds__(NTHREADS, 2) yoco_fwd(Args a) {
    extern __shared__ __attribute__((aligned(16))) unsigned char lds_raw[];
    cg::grid_group grid = cg::this_grid();
    LAS unsigned char* lds = (LAS unsigned char*)lds_raw;
    const int wave = __builtin_amdgcn_readfirstlane(threadIdx.x >> 6);
    const int G = gridDim.x, bx = blockIdx.x;
    const int gw = bx * NWAVES + wave, ngw = G * NWAVES;
    unsigned char* ws = a.ws;
    bf16* Wqkv_t = (bf16*)(ws + WS_WQKV); bf16* Wo_t = (bf16*)(ws + WS_WO); bf16* Wkv_t = (bf16*)(ws + WS_WKV); bf16* Wsq_t = (bf16*)(ws + WS_WSQ); bf16* Wso_t = (bf16*)(ws + WS_WSO);
    bf16* Wgu_t = (bf16*)(ws + WS_WGU); bf16* Wd_t = (bf16*)(ws + WS_WD);
    bf16* XN = (bf16*)(ws + WS_XN); bf16* QB = (bf16*)(ws + WS_BIG); bf16* KB = QB + (size_t)MTOK * DM; bf16* VTB = KB + (size_t)MTOK * DM; bf16* MID = QB; bf16* XNKV = KB;
    bf16* KS = (bf16*)(ws + WS_KS); bf16* VTS = (bf16*)(ws + WS_VTS);

    {
        LAS float* scr = (LAS float*)(lds + wave * 16384);
        const int lane = fresh_tid() & 63;
        constexpr int I_QKV = 32 * 192, I_SQ = 32 * 64, I_KV = 32 * 128, I_G = 32 * 176, I_D = 88 * 64;
        constexpr int NITEMS = 2 * I_QKV + 2 * I_SQ + I_KV + 4 * I_SQ + 4 * (2 * I_G + I_D);
        for (int it = gw; it < NITEMS; it += ngw) {
            int r = it;
            if (r < 2 * I_QKV) { const int l = r / I_QKV; transpose_item(a.w_qkv + (size_t)l * DM * 6144, DM, 6144, Wqkv_t + (size_t)l * 6144 * DM, 0, scr, r % I_QKV, lane); continue; } r -= 2 * I_QKV;
            if (r < 2 * I_SQ) { const int l = r / I_SQ; transpose_item(a.w_o + (size_t)l * DM * DM, DM, DM, Wo_t + (size_t)l * DM * DM, 0, scr, r % I_SQ, lane); continue; } r -= 2 * I_SQ;
            if (r < I_KV) { transpose_item(a.w_kv, DM, 4096, Wkv_t, 0, scr, r, lane); continue; } r -= I_KV;
            if (r < 2 * I_SQ) { const int l = r / I_SQ; transpose_item(a.w_sq + (size_t)l * DM * DM, DM, DM, Wsq_t + (size_t)l * DM * DM, 0, scr, r % I_SQ, lane); continue; } r -= 2 * I_SQ;
            if (r < 2 * I_SQ) { const int l = r / I_SQ; transpose_item(a.w_so + (size_t)l * DM * DM, DM, DM, Wso_t + (size_t)l * DM * DM, 0, scr, r % I_SQ, lane); continue; } r -= 2 * I_SQ;
            if (r < 4 * I_G) { const int l = r / I_G; transpose_item(a.w_gate + (size_t)l * DM * FF, DM, FF, Wgu_t + (size_t)l * 2 * FF * DM, 1, scr, r % I_G, lane); continue; } r -= 4 * I_G;
            if (r < 4 * I_G) { const int l = r / I_G; transpose_item(a.w_up + (size_t)l * DM * FF, DM, FF, Wgu_t + (size_t)l * 2 * FF * DM, 2, scr, r % I_G, lane); continue; } r -= 4 * I_G;
            { const int l = r / I_D; transpose_item(a.w_down + (size_t)l * FF * DM, FF, DM, Wd_t + (size_t)l * DM * FF, 0, scr, r % I_D, lane); }
        }
        norm_rows(a.x, a.attn_g, XN, nullptr, nullptr, gw, ngw);
    }
    grid.sync();

    for (int l = 0; l < 4; ++l) {
        const bool diff = l < 2;
        const float* hsrc = (l == 0) ? a.x : a.out;
        if (l > 0) {
            if (l == 2) norm_rows(a.out, a.attn_g + l * DM, XN, a.kv_g, XNKV, gw, ngw);
            else norm_rows(a.out, a.attn_g + l * DM, XN, nullptr, nullptr, gw, ngw);
            grid.sync();
        }
        {
            pg8::Gemm g{XN, diff ? Wqkv_t + (size_t)l * 6144 * DM : Wsq_t + (size_t)(l - 2) * DM * DM, MTOK, diff ? 4096 : 2048, DM};
            pg8::StaticOrder S; S.init(g.M, g.N, G, bx);
            pg8::EpiBf16 E{QB, DM, 2048, (size_t)MTOK * DM, diff ? 0.125f * LOG2E : 0.08838834764831845f};
            pg8::gemm_phase<pg8::EpiBf16, pg8::StaticOrder, true, true>(lds, g, S, E);
        }
        if (diff || l == 2) {
            pg8::Gemm g{diff ? Wqkv_t + (size_t)l * 6144 * DM + (size_t)4096 * DM : Wkv_t + (size_t)2048 * DM, diff ? XN : XNKV, DM, MTOK, DM};
            pg8::StaticOrder S; S.init(g.M, g.N, G, bx);
            pg8::EpiVT E{diff ? VTB : VTS};
            pg8::gemm_phase<pg8::EpiVT, pg8::StaticOrder, true, true>(lds, g, S, E);
        }
        if (l == 2) {
            pg8::Gemm g{XNKV, Wkv_t, MTOK, DM, DM};
            pg8::StaticOrder S; S.init(g.M, g.N, G, bx);
            pg8::EpiBf16 E{KS, DM, 0, 0, 1.f};
            pg8::gemm_phase<pg8::EpiBf16, pg8::StaticOrder, true, true>(lds, g, S, E);
        }
        grid.sync();
        if (diff) {
            const float lam_init = (l == 0) ? 0.2f : 0.35550906759f;
            float lam;
            const int tid = fresh_tid(), lane = tid & 63;
            { const float p1 = a.lq1[l * 64 + lane] * a.lk1[l * 64 + lane], p2 = a.lq2[l * 64 + lane] * a.lk2[l * 64 + lane];
              lam = expf(wave_sum(p1)) - expf(wave_sum(p2)) + lam_init; }
            int curh = -1;
            for (int i = 0;; ++i) {
                const int pos = i * G + ((i & 1) ? (G - 1 - bx) : bx);
                if (pos >= dattn::NUNITS) break;
                const int qb = 63 - pos / 32, bh = pos % 32, b = bh >> 4, h = bh & 15;
                if (h != curh) {
                    const int tl = fresh_tid();
                    if (tl < 129) { const int n = tl - 1; int bucket;
                        if (n < 16) bucket = n < 0 ? 0 : n; else { int lg = 16 + (int)(logf((float)n / 16.0f) / 2.0794415416798357f * 16.0f); bucket = lg < 31 ? lg : 31; }
                        const float v = (a.rel_bias[bucket * 16 + h] - a.rel_bias[31 * 16 + h]) * LOG2E;
                        ((LAS float*)(lds + dattn::LUT_OFF))[tl] = (n < 0) ? -INFINITY : v; }
                    curh = h;
                    __syncthreads();
                }
                dattn::unit(b, h, qb, QB, KB, VTB, XN, lds, lam, a.subln_g + l * 128, 1.0f - lam_init);
            }
        } else {
            for (int u = gw; u < sbattn::NUNITS; u += ngw) {
                const int bh = u >> 8, qblk = u & 255;
                sbattn::unit(bh >> 4, bh & 15, qblk, QB, KS, VTS, XN);
            }
        }
        grid.sync();
        {
            pg8::Gemm g{XN, diff ? Wo_t + (size_t)l * DM * DM : Wso_t + (size_t)(l - 2) * DM * DM, MTOK, DM, DM};
            pg8::StaticOrder S; S.init(g.M, g.N, G, bx);
            pg8::EpiRes E{hsrc, a.out, DM};
            pg8::gemm_phase<pg8::EpiRes, pg8::StaticOrder, true, true>(lds, g, S, E);
        }
        grid.sync();
        norm_rows(a.out, a.ffn_g + l * DM, XN, nullptr, nullptr, gw, ngw);
        grid.sync();
        {
            pg8::Gemm g{XN, Wgu_t + (size_t)l * 2 * FF * DM, MTOK, 2 * FF, DM};
            pg8::StaticOrder S; S.init(g.M, g.N, G, bx);
            pg8::EpiSwiGLU E{MID, FF};
            pg8::gemm_phase<pg8::EpiSwiGLU, pg8::StaticOrder, true, true>(lds, g, S, E);
        }
        grid.sync();
        {
            pg8::Gemm g{MID, Wd_t + (size_t)l * DM * FF, MTOK, DM, FF};
            pg8::StaticOrder S; S.init(g.M, g.N, G, bx);
            pg8::EpiRes E{a.out, a.out, DM};
            pg8::gemm_phase<pg8::EpiRes, pg8::StaticOrder, true, true>(lds, g, S, E);
        }
        grid.sync();
    }
    final_norm(a.out, a.final_g, gw, ngw);
}

extern "C" void kernel_launch(void* const* d_in, const int* in_sizes, int n_in, void* d_out, int out_size, void* d_ws, size_t ws_size, hipStream_t stream) {
    static int grid = 0;
    if (grid == 0) {
        if (n_in != 19 || ws_size < WS_END) { fprintf(stderr, "kernel_launch: unexpected inputs (%d) or workspace (%zu < %zu)\n", n_in, ws_size, (size_t)WS_END); grid = -1; return; }
        int dev = 0, cus = 0, per_cu = 0;
        hipGetDevice(&dev); hipDeviceGetAttribute(&cus, hipDeviceAttributeMultiprocessorCount, dev);
        hipFuncSetAttribute((const void*)yoco_fwd, hipFuncAttributeMaxDynamicSharedMemorySize, LDS_BYTES);
        hipOccupancyMaxActiveBlocksPerMultiprocessor(&per_cu, (const void*)yoco_fwd, NTHREADS, LDS_BYTES);
        (void)hipGetLastError();
        if (per_cu < 1) per_cu = 1;
        grid = cus * per_cu;
    }
    if (grid < 0) return;
    Args a{};
    a.x = (const float*)d_in[0]; a.rel_bias = (const float*)d_in[1]; a.attn_g = (const float*)d_in[2]; a.ffn_g = (const float*)d_in[3]; a.w_qkv = (const float*)d_in[4]; a.w_o = (const float*)d_in[5];
    a.lq1 = (const float*)d_in[6]; a.lk1 = (const float*)d_in[7]; a.lq2 = (const float*)d_in[8]; a.lk2 = (const float*)d_in[9]; a.subln_g = (const float*)d_in[10]; a.kv_g = (const float*)d_in[11];
    a.w_kv = (const float*)d_in[12]; a.w_sq = (const float*)d_in[13]; a.w_so = (const float*)d_in[14]; a.w_gate = (const float*)d_in[15]; a.w_up = (const float*)d_in[16]; a.w_down = (const float*)d_in[17]; a.final_g = (const float*)d_in[18];
    a.out = (float*)d_out; a.ws = (unsigned char*)d_ws;
    void* args[] = {&a};
    hipError_t e = hipLaunchCooperativeKernel((const void*)yoco_fwd, dim3(grid), dim3(NTHREADS), args, LDS_BYTES, stream);
    if (e != hipSuccess) fprintf(stderr, "cooperative launch failed: %s (grid %d)\n", hipGetErrorString(e), grid);
}
```

```cpp
#include <hip/hip_runtime.h>
#include <hip/hip_cooperative_groups.h>
#include <cstdio>
#include <cstdint>
#include <cmath>
namespace cg = cooperative_groups;
namespace pg8 {
#define PG8_LAS __attribute__((address_space(3)))
typedef unsigned short bf16_t;
typedef short bf16x8 __attribute__((ext_vector_type(8)));
typedef float f32x4 __attribute__((ext_vector_type(4)));
typedef unsigned u32x4 __attribute__((ext_vector_type(4)));
constexpr int BM = 256, BK = 64, HALF = 128, HTB = HALF * BK * 2  , STAGE_BYTES = 8 * HTB, NXCD = 8, WGM = 8;

__host__ __device__ __forceinline__ int lds_byte(int r, int c) { const int st = (r >> 4) * 2 + (c >> 5), rr = r & 15, cc = c & 31, ob = rr * 64 + cc * 2; return st * 1024 + (ob ^ (((ob >> 9) & 1) << 5)); }
__host__ __device__ __forceinline__ void stage_rc(int b, int& R, int& C) { const int st = b / 1024, sb = b % 1024, swz = sb ^ (((sb >> 9) & 1) << 5); R = (st >> 1) * 16 + swz / 64; C = (st & 1) * 32 + (swz % 64) / 2; }
__host__ __device__ __forceinline__ int perm32(int rho) { const int n = rho >> 4, i = rho & 15; return 8 * (i >> 2) + 4 * n + (i & 3); }

struct Unit { int pm, pn; };
struct Gemm { const bf16_t* A; const bf16_t* Bt; int M, N, K; };

struct StaticOrder {
    int nM, nN, nwg, G, c;
    __host__ __device__ void init(int M, int N, int G_, int c_) { nM = M / BM; nN = N / BM; nwg = nM * nN; G = G_; c = c_; }
    __host__ __device__ bool next(int i, Unit& u) const {
        const long L = (long)i * G + c; if (L >= nwg) return false;
        int wgid = (int)L; { const int q = nwg / NXCD, r = nwg % NXCD, xcd = wgid % NXCD, off = wgid / NXCD; wgid = (xcd < r ? xcd * (q + 1) : r * (q + 1) + (xcd - r) * q) + off; }
        const int nig = WGM * nN, gid = wgid / nig, fm = gid * WGM, gsz = (nM - fm) < WGM ? (nM - fm) : WGM;
        u.pm = fm + ((wgid % nig) % gsz); u.pn = (wgid % nig) / gsz; return true;
    }
    __device__ __forceinline__ void a_ready(const Unit&) const {}
    __device__ __forceinline__ void done(const Unit&) const {}
};

__device__ __forceinline__ unsigned cvt_pk_bf16(float lo, float hi) { unsigned r; asm volatile("v_cvt_pk_bf16_f32 %0, %1, %2" : "=v"(r) : "v"(lo), "v"(hi)); return r; }
typedef float f32x2 __attribute__((ext_vector_type(2)));

typedef unsigned u32x2e __attribute__((ext_vector_type(2)));
__device__ __forceinline__ float row_rs(const float* part, int row) {
    const f32x4* p = (const f32x4*)(part + (size_t)row * 32); f32x4 s = p[0];
#pragma unroll
    for (int i = 1; i < 8; ++i) s += p[i];
    return __builtin_amdgcn_rsqf(((s[0] + s[1]) + (s[2] + s[3])) * (1.0f / 2048.0f) + 1e-5f);
}


template <bool COLS, class Sched> __device__ __forceinline__ void build_rtab(PG8_LAS float* tab, const float* part, const Sched& S) {
    int t_ = threadIdx.x; asm volatile("" : "+v"(t_));
    Unit u;
    for (int i = 0; i < 14 && S.next(i, u); ++i) { const int base = (COLS ? u.pn : u.pm) * BM; if (t_ < 256) tab[i * 256 + t_] = row_rs(part, base + t_); }
    __syncthreads();
}
struct EpiBf16 {
    static constexpr bool PERM = true, AFTER_DRAIN = false;
    bf16_t* O; int ldc; int split_cols; size_t split_stride; float scale0; const PG8_LAS float* rtab;
    __device__ __forceinline__ void operator()(const f32x4 (&acc)[2][2][4][2], const Unit& u, int ui, int wr, int wc, int fr, int fq) const {
        const int row0 = u.pm * BM + wr * 64 + fr; int colt = u.pn * BM; bf16_t* base = O;
        float sc = 1.f; if (split_cols) { const int t = colt / split_cols; base += (size_t)t * split_stride; colt -= t * split_cols; if (t == 0) sc = scale0; }
        const int col0 = colt + wc * 32 + 8 * fq;
#pragma unroll
        for (int ai = 0; ai < 2; ++ai)
#pragma unroll
            for (int m = 0; m < 4; ++m) { bf16_t* rowp = base + (size_t)(row0 + ai * HALF + m * 16) * ldc + col0;
                const float rsc = sc * rtab[ui * 256 + wr * 64 + fr + ai * HALF + m * 16];
#pragma unroll
                for (int bj = 0; bj < 2; ++bj) { f32x4 v0 = acc[ai][bj][m][0] * rsc, v1 = acc[ai][bj][m][1] * rsc;
                    u32x4 w; w.x = cvt_pk_bf16(v0[0], v0[1]); w.y = cvt_pk_bf16(v0[2], v0[3]); w.z = cvt_pk_bf16(v1[0], v1[1]); w.w = cvt_pk_bf16(v1[2], v1[3]);
                    *(u32x4*)(rowp + bj * HALF) = w; } }
    }
};
struct EpiRes {
    static constexpr bool PERM = false, AFTER_DRAIN = false;
    const float* base; float* out; int ldc;
    __device__ __forceinline__ void operator()(const f32x4 (&acc)[2][2][4][2], const Unit& u, int ui, int wr, int wc, int fr, int fq) const {
        const int col0 = u.pn * BM + wc * 32 + 4 * fq;
#pragma unroll
        for (int ai = 0; ai < 2; ++ai)
#pragma unroll
            for (int m = 0; m < 4; ++m) { const size_t off = (size_t)(u.pm * BM + ai * HALF + wr * 64 + m * 16 + fr) * ldc + col0;
#pragma unroll
                for (int bj = 0; bj < 2; ++bj)
#pragma unroll
                    for (int n = 0; n < 2; ++n) { const f32x4 bs = *(const f32x4*)(base + off + bj * HALF + n * 16); *(f32x4*)(out + off + bj * HALF + n * 16) = bs + acc[ai][bj][m][n]; } }
    }
};
struct EpiSwiGLU {
    static constexpr bool PERM = true, AFTER_DRAIN = false;
    bf16_t* O; int ldc; const PG8_LAS float* rtab;
    __device__ __forceinline__ static float silu_mul(float g, float u) { return g * u * __builtin_amdgcn_rcpf(1.0f + __builtin_amdgcn_exp2f(-1.4426950408889634f * g)); }
    __device__ __forceinline__ void operator()(const f32x4 (&acc)[2][2][4][2], const Unit& u, int ui, int wr, int wc, int fr, int fq) const {
        const int row0 = u.pm * BM + wr * 64 + fr; const int col0 = u.pn * HALF + wc * 32 + 8 * fq;
#pragma unroll
        for (int ai = 0; ai < 2; ++ai)
#pragma unroll
            for (int m = 0; m < 4; ++m) { bf16_t* rowp = O + (size_t)(row0 + ai * HALF + m * 16) * ldc + col0;
                const float rsc = rtab[ui * 256 + wr * 64 + fr + ai * HALF + m * 16];
                const f32x4 g0 = acc[ai][0][m][0] * rsc, g1 = acc[ai][0][m][1] * rsc, u0 = acc[ai][1][m][0] * rsc, u1 = acc[ai][1][m][1] * rsc;
                u32x4 w; w.x = cvt_pk_bf16(silu_mul(g0[0], u0[0]), silu_mul(g0[1], u0[1])); w.y = cvt_pk_bf16(silu_mul(g0[2], u0[2]), silu_mul(g0[3], u0[3]));
                w.z = cvt_pk_bf16(silu_mul(g1[0], u1[0]), silu_mul(g1[1], u1[1])); w.w = cvt_pk_bf16(silu_mul(g1[2], u1[2]), silu_mul(g1[3], u1[3]));
                *(u32x4*)rowp = w; }
    }
};

struct EpiVT {
    static constexpr bool PERM = true, AFTER_DRAIN = false;
    bf16_t* O; const PG8_LAS float* rtab;
    __device__ __forceinline__ void operator()(const f32x4 (&acc)[2][2][4][2], const Unit& u, int ui, int wr, int wc, int fr, int fq) const {
        const int row0 = u.pm * BM + wr * 64 + fr; const int col0 = u.pn * BM + wc * 32 + 8 * fq;
        f32x4 cs[2][2];
#pragma unroll
        for (int bj = 0; bj < 2; ++bj)
#pragma unroll
            for (int n = 0; n < 2; ++n) cs[bj][n] = *(const PG8_LAS f32x4*)(rtab + ui * 256 + wc * 32 + 8 * fq + bj * HALF + 4 * n);
#pragma unroll
        for (int ai = 0; ai < 2; ++ai)
#pragma unroll
            for (int m = 0; m < 4; ++m) { const int ch = row0 + ai * HALF + m * 16;
#pragma unroll
                for (int bj = 0; bj < 2; ++bj) { const int col = col0 + bj * HALF; const f32x4 v0 = acc[ai][bj][m][0] * cs[bj][0], v1 = acc[ai][bj][m][1] * cs[bj][1];
                    u32x4 w; w.x = cvt_pk_bf16(v0[0], v0[1]); w.y = cvt_pk_bf16(v0[2], v0[3]); w.z = cvt_pk_bf16(v1[0], v1[1]); w.w = cvt_pk_bf16(v1[2], v1[3]);
                    *(u32x4*)(O + ((size_t)(col >> 6) * 2048 + ch) * 64 + (col & 63)) = w; } }
    }
};

struct EpiResN {
    static constexpr bool PERM = false, AFTER_DRAIN = false;
    const float* base; float* out; int ldc; bf16_t* XH; float* ssq;
    __device__ __forceinline__ void operator()(const f32x4 (&acc)[2][2][4][2], const Unit& u, int ui, int wr, int wc, int fr, int fq) const {
        const int col0 = u.pn * BM + wc * 32 + 4 * fq; const int rowb = u.pm * BM + wr * 64 + fr;
        f32x4 nxt[2][2];
#pragma unroll
        for (int bj = 0; bj < 2; ++bj)
#pragma unroll
            for (int n = 0; n < 2; ++n) nxt[bj][n] = *(const f32x4*)(base + (size_t)rowb * ldc + col0 + bj * HALF + n * 16);
#pragma unroll
        for (int g = 0; g < 8; ++g) { const int ai = g >> 2, m = g & 3; const int row = rowb + ai * HALF + m * 16; const size_t off = (size_t)row * ldc + col0;
            f32x4 cur[2][2];
#pragma unroll
            for (int bj = 0; bj < 2; ++bj)
#pragma unroll
                for (int n = 0; n < 2; ++n) cur[bj][n] = nxt[bj][n];
            if (g + 1 < 8) { const int row2 = rowb + ((g + 1) >> 2) * HALF + ((g + 1) & 3) * 16;
#pragma unroll
                for (int bj = 0; bj < 2; ++bj)
#pragma unroll
                    for (int n = 0; n < 2; ++n) nxt[bj][n] = *(const f32x4*)(base + (size_t)row2 * ldc + col0 + bj * HALF + n * 16); }
            float ss = 0.f;
#pragma unroll
            for (int bj = 0; bj < 2; ++bj)
#pragma unroll
                for (int n = 0; n < 2; ++n) { const f32x4 v = cur[bj][n] + acc[ai][bj][m][n]; *(f32x4*)(out + off + bj * HALF + n * 16) = v;
                    if (XH) { u32x2e w; w.x = cvt_pk_bf16(v[0], v[1]); w.y = cvt_pk_bf16(v[2], v[3]); *(u32x2e*)(XH + off + bj * HALF + n * 16) = w; }
                    ss += (v[0] * v[0] + v[1] * v[1]) + (v[2] * v[2] + v[3] * v[3]); }
            if (XH) {
            ss += __int_as_float(__builtin_amdgcn_ds_swizzle(__float_as_int(ss), (16 << 10) | 0x1f));
            { auto rr = __builtin_amdgcn_permlane32_swap(__float_as_uint(ss), __float_as_uint(ss), false, false); ss = __uint_as_float(rr[0]) + __uint_as_float(rr[1]); }
            if (fq == 0) ssq[(size_t)row * 32 + u.pn * 4 + wc] = ss; } }
    }
};

template <class Epi, class Sched, bool ALIGN_EPI = false, bool SP2 = false>
__device__ __forceinline__ void gemm_phase(PG8_LAS unsigned char* lds, const Gemm g, const Sched& S, const Epi& E) {
    int tid_ = threadIdx.x; asm volatile("" : "+v"(tid_));
    const int tid = tid_, wid = __builtin_amdgcn_readfirstlane(tid >> 6), lane = tid & 63, wr = wid >> 2, wc = wid & 3, fr = lane & 15, fq = lane >> 4;
    const int K = g.K, nt = K / BK;
    unsigned voffA[2], voffB[2];
#pragma unroll
    for (int i = 0; i < 2; ++i) { int R, C; stage_rc(tid * 16 + i * 8192, R, C); const int Rb = Epi::PERM ? ((R & ~31) + perm32(R & 31)) : R;
        voffA[i] = (unsigned)(R * K + C) * 2u; voffB[i] = (unsigned)(Rb * K + C) * 2u; }
    const size_t kstep = (size_t)(BK * 2);
    const size_t hstep = (size_t)HALF * K * 2;
    const size_t tstep = 2 * hstep;
    const unsigned ldsw = (unsigned)wid * 1024u;
    const int aoff = lds_byte(wr * 64 + fr, fq * 8), boff = lds_byte(wc * 32 + fr, fq * 8);
#define PG8_SA(b, h) (((b) * 2 + (h)) * HTB)
#define PG8_SB(b, h) ((4 + (b) * 2 + (h)) * HTB)
#define PG8_STAGE(bufoff, gbase, voff) do { _Pragma("unroll") for (int _i = 0; _i < 2; ++_i) \
        __builtin_amdgcn_global_load_lds((const unsigned*)((const char*)(gbase) + (voff)[_i]), (PG8_LAS unsigned*)(lds + (bufoff) + ldsw + _i * 8192), 16, 0, 0); } while (0)
#define PG8_LDA(dst, b, h) do { _Pragma("unroll") for (int m = 0; m < 4; ++m) _Pragma("unroll") for (int k = 0; k < 2; ++k) dst[m][k] = *(const PG8_LAS bf16x8*)(lds + PG8_SA(b, h) + aoff + m * 2048 + k * 1024); } while (0)
#define PG8_LDB(dst, b, h) do { _Pragma("unroll") for (int n = 0; n < 2; ++n) _Pragma("unroll") for (int k = 0; k < 2; ++k) dst[n][k] = *(const PG8_LAS bf16x8*)(lds + PG8_SB(b, h) + boff + n * 2048 + k * 1024); } while (0)
#define PG8_MMA(ai, bj, At, Bt) do { __builtin_amdgcn_s_setprio(1); _Pragma("unroll") for (int m = 0; m < 4; ++m) _Pragma("unroll") for (int n = 0; n < 2; ++n) _Pragma("unroll") for (int k = 0; k < 2; ++k) \
        acc[ai][bj][m][n] = __builtin_amdgcn_mfma_f32_16x16x32_bf16(Bt[n][k], At[m][k], acc[ai][bj][m][n], 0, 0, 0); __builtin_amdgcn_s_setprio(0); } while (0)
#define PG8_WAIT_V(n) asm volatile("s_waitcnt vmcnt(" #n ")" ::: "memory")
#define PG8_WAIT_L(n) asm volatile("s_waitcnt lgkmcnt(" #n ")" ::: "memory")
#define PG8_BAR __builtin_amdgcn_s_barrier()
#define PG8_SCHED __builtin_amdgcn_sched_barrier(0)
    Unit cur, nxt; int ui = 0;
    if (!S.next(0, cur)) return;
    f32x4 acc[2][2][4][2];
#pragma unroll
    for (int a = 0; a < 2; ++a)
#pragma unroll
        for (int b = 0; b < 2; ++b)
#pragma unroll
            for (int m = 0; m < 4; ++m)
#pragma unroll
                for (int n = 0; n < 2; ++n) acc[a][b][m][n] = (f32x4){0.f, 0.f, 0.f, 0.f};
    bf16x8 At[4][2], B0[2][2], B1[2][2];
    const char* cA = (const char*)g.A + (size_t)cur.pm * tstep; const char* cB = (const char*)g.Bt + (size_t)cur.pn * tstep;
    S.a_ready(cur);
    if constexpr (SP2) {
        PG8_STAGE(PG8_SB(0, 0), cB, voffB); PG8_STAGE(PG8_SB(0, 1), cB + hstep, voffB); PG8_STAGE(PG8_SA(0, 0), cA, voffA); PG8_STAGE(PG8_SA(0, 1), cA + hstep, voffA);
        if (wr == 1) PG8_BAR;
        PG8_WAIT_V(2); PG8_BAR;
        PG8_STAGE(PG8_SB(1, 0), cB + kstep, voffB); PG8_STAGE(PG8_SA(1, 0), cA + kstep, voffA); PG8_STAGE(PG8_SB(1, 1), cB + hstep + kstep, voffB);
        PG8_WAIT_V(6); PG8_BAR;
    } else {
        PG8_STAGE(PG8_SB(0, 0), cB, voffB); PG8_STAGE(PG8_SA(0, 0), cA, voffA); PG8_STAGE(PG8_SB(0, 1), cB + hstep, voffB); PG8_STAGE(PG8_SA(0, 1), cA + hstep, voffA);
        if (wr == 1) PG8_BAR;
        PG8_WAIT_V(4); PG8_BAR;
        PG8_STAGE(PG8_SB(1, 0), cB + kstep, voffB); PG8_STAGE(PG8_SA(1, 0), cA + kstep, voffA); PG8_STAGE(PG8_SB(1, 1), cB + hstep + kstep, voffB);
        PG8_WAIT_V(6); PG8_BAR;
    }
    for (;;) {
        const bool has_next = S.next(ui + 1, nxt);
        const char* nA = has_next ? (const char*)g.A + (size_t)nxt.pm * tstep : cA; const char* nB = has_next ? (const char*)g.Bt + (size_t)nxt.pn * tstep : cB;
        for (int t = 0; t < nt; t += 2) {
            const bool last = (t == nt - 2);
            const char* a1 = cA + (size_t)(t + 1) * kstep;
            const char* a2 = last ? nA : cA + (size_t)(t + 2) * kstep; const char* b2 = last ? nB : cB + (size_t)(t + 2) * kstep;
            const char* a3 = a2 + kstep; const char* b3 = b2 + kstep;
            if (last && has_next) S.a_ready(nxt);
            if constexpr (SP2) {
            PG8_LDB(B0, 0, 0); PG8_LDB(B1, 0, 1); PG8_SCHED; PG8_LDA(At, 0, 0); PG8_STAGE(PG8_SA(1, 1), a1 + hstep, voffA);
            PG8_WAIT_V(8); PG8_WAIT_L(0); PG8_BAR; PG8_MMA(0, 0, At, B0); PG8_MMA(0, 1, At, B1); PG8_BAR; PG8_SCHED;
            PG8_LDA(At, 0, 1); PG8_STAGE(PG8_SB(0, 0), b2, voffB); PG8_STAGE(PG8_SB(0, 1), b2 + hstep, voffB); PG8_STAGE(PG8_SA(0, 0), a2, voffA);
            PG8_WAIT_V(8); PG8_WAIT_L(0); PG8_BAR; PG8_MMA(1, 0, At, B0); PG8_MMA(1, 1, At, B1); PG8_BAR; PG8_SCHED;
            PG8_LDB(B0, 1, 0); PG8_LDB(B1, 1, 1); PG8_SCHED; PG8_LDA(At, 1, 0); PG8_STAGE(PG8_SA(0, 1), a2 + hstep, voffA);
            PG8_WAIT_V(8); PG8_WAIT_L(0); PG8_BAR; PG8_MMA(0, 0, At, B0); PG8_MMA(0, 1, At, B1); PG8_BAR; PG8_SCHED;
            PG8_LDA(At, 1, 1); PG8_STAGE(PG8_SB(1, 0), b3, voffB); PG8_STAGE(PG8_SB(1, 1), b3 + hstep, voffB); PG8_STAGE(PG8_SA(1, 0), a3, voffA);
            PG8_WAIT_V(8); PG8_WAIT_L(0); PG8_BAR; PG8_MMA(1, 0, At, B0); PG8_MMA(1, 1, At, B1); PG8_BAR; PG8_SCHED;
            } else {
            PG8_LDB(B0, 0, 0); PG8_SCHED; PG8_LDA(At, 0, 0); PG8_STAGE(PG8_SA(1, 1), a1 + hstep, voffA);
            PG8_WAIT_L(8); PG8_BAR; PG8_WAIT_L(0); PG8_MMA(0, 0, At, B0); PG8_BAR; PG8_SCHED;
            PG8_LDB(B1, 0, 1); PG8_STAGE(PG8_SB(0, 0), b2, voffB);
            PG8_BAR; PG8_WAIT_L(0); PG8_MMA(0, 1, At, B1); PG8_BAR;
            PG8_LDA(At, 0, 1); PG8_STAGE(PG8_SA(0, 0), a2, voffA);
            PG8_BAR; PG8_WAIT_L(0); PG8_MMA(1, 0, At, B0); PG8_BAR; PG8_SCHED;
            PG8_STAGE(PG8_SB(0, 1), b2 + hstep, voffB);
            PG8_WAIT_V(6); PG8_BAR; PG8_MMA(1, 1, At, B1); PG8_BAR;
            PG8_LDB(B0, 1, 0); PG8_SCHED; PG8_LDA(At, 1, 0); PG8_STAGE(PG8_SA(0, 1), a2 + hstep, voffA);
            PG8_WAIT_L(8); PG8_BAR; PG8_WAIT_L(0); PG8_MMA(0, 0, At, B0); PG8_BAR; PG8_SCHED;
            PG8_LDB(B1, 1, 1); PG8_STAGE(PG8_SB(1, 0), b3, voffB);
            PG8_BAR; PG8_WAIT_L(0); PG8_MMA(0, 1, At, B1); PG8_BAR;
            PG8_LDA(At, 1, 1); PG8_STAGE(PG8_SA(1, 0), a3, voffA);
            PG8_BAR; PG8_WAIT_L(0); PG8_MMA(1, 0, At, B0); PG8_BAR; PG8_SCHED;
            PG8_STAGE(PG8_SB(1, 1), b3 + hstep, voffB);
            PG8_WAIT_V(6); PG8_BAR; PG8_MMA(1, 1, At, B1); PG8_BAR;
            }
        }
        if constexpr (ALIGN_EPI) { if (wr == 0) PG8_BAR; }
        if constexpr (!Epi::AFTER_DRAIN) { E(acc, cur, ui, wr, wc, fr, fq); S.done(cur); }
        if (!has_next) break;
#pragma unroll
        for (int a = 0; a < 2; ++a)
#pragma unroll
            for (int b = 0; b < 2; ++b)
#pragma unroll
                for (int m = 0; m < 4; ++m)
#pragma unroll
                    for (int n = 0; n < 2; ++n) acc[a][b][m][n] = (f32x4){0.f, 0.f, 0.f, 0.f};
        cur = nxt; cA = nA; cB = nB; ++ui;
        if constexpr (ALIGN_EPI) { if (wr == 1) PG8_BAR; }
    }
    PG8_WAIT_V(0);
    if constexpr (!ALIGN_EPI) { if (wr == 0) PG8_BAR; }
    PG8_BAR;
    if constexpr (Epi::AFTER_DRAIN) { E.fused(acc, cur, wr, wc, fr, fq, lds, wid, lane); S.done(cur); }
#undef PG8_SA
#undef PG8_SB
#undef PG8_STAGE
#undef PG8_LDA
#undef PG8_LDB
#undef PG8_MMA
#undef PG8_WAIT_V
#undef PG8_WAIT_L
#undef PG8_BAR
#undef PG8_SCHED
}
}

#define LAS __attribute__((address_space(3)))
typedef unsigned short bf16;
typedef short bf16x8 __attribute__((ext_vector_type(8)));
typedef float f32x4 __attribute__((ext_vector_type(4)));
typedef float f32x16 __attribute__((ext_vector_type(16)));
typedef unsigned u32x4 __attribute__((ext_vector_type(4)));
typedef unsigned u32x2 __attribute__((ext_vector_type(2)));

constexpr int NWAVES = 8, NTHREADS = 512;
constexpr int BATCH = 2, SEQ = 8192, DM = 2048, FF = 5632, MTOK = BATCH * SEQ;
constexpr float RMS_EPS = 1e-5f;
constexpr float LOG2E = 1.4426950408889634f, LN2 = 0.6931471805599453f;
constexpr int LDS_BYTES = 147456;

constexpr size_t MiB = 1u << 20;
constexpr size_t WS_WQKV = 2 * MiB;
constexpr size_t WS_WO   = WS_WQKV + 48 * MiB;
constexpr size_t WS_WKV  = WS_WO + 16 * MiB;
constexpr size_t WS_WSQ  = WS_WKV + 16 * MiB;
constexpr size_t WS_WSO  = WS_WSQ + 16 * MiB;
constexpr size_t WS_WGU  = WS_WSO + 16 * MiB;
constexpr size_t WS_WD   = WS_WGU + 176 * MiB;
constexpr size_t WS_XN   = WS_WD + 88 * MiB;
constexpr size_t WS_BIG  = WS_XN + 64 * MiB;
constexpr size_t WS_KS   = WS_BIG + 192 * MiB;
constexpr size_t WS_VTS  = WS_KS + 64 * MiB;
constexpr size_t WS_XH   = WS_VTS + 64 * MiB;
constexpr size_t WS_SSQ  = WS_XH + 64 * MiB;
constexpr size_t WS_END  = WS_SSQ + 18 * MiB;

__device__ __forceinline__ int fresh_tid() { int t = threadIdx.x; asm volatile("" : "+v"(t)); return t; }
#define SWZ_XOR(v, k) __int_as_float(__builtin_amdgcn_ds_swizzle(__float_as_int(v), ((k) << 10) | 0x1f))
__device__ __forceinline__ float wave_sum(float v) {
    v += SWZ_XOR(v, 1); v += SWZ_XOR(v, 2); v += SWZ_XOR(v, 4); v += SWZ_XOR(v, 8); v += SWZ_XOR(v, 16);
    auto rr = __builtin_amdgcn_permlane32_swap(__float_as_uint(v), __float_as_uint(v), false, false);
    return __uint_as_float(rr[0]) + __uint_as_float(rr[1]);
}
__device__ __forceinline__ unsigned cvtpk(float lo, float hi) { unsigned r; asm volatile("v_cvt_pk_bf16_f32 %0, %1, %2" : "=v"(r) : "v"(lo), "v"(hi)); return r; }
__device__ __forceinline__ float swap32(float v) {
    auto rr = __builtin_amdgcn_permlane32_swap(__float_as_uint(v), __float_as_uint(v), false, false);
    return (threadIdx.x & 32) ? __uint_as_float(rr[0]) : __uint_as_float(rr[1]);
}

__device__ __forceinline__ void transpose_item(const float* W, int K, int N, bf16* WT, int mode, LAS float* scr, int item, int lane, const float* gain = nullptr) {
    const int nblk = N / 32, kb = item / nblk, nb = item % nblk, k0 = 64 * kb, n0 = 32 * nb;
    int drow = n0;
    if (mode == 1) drow = 256 * (n0 >> 7) + (n0 & 127);
    if (mode == 2) drow = 256 * (n0 >> 7) + 128 + (n0 & 127);
    {
        f32x4 wv[8];
#pragma unroll
        for (int i = 0; i < 8; ++i) { const int f = i * 64 + lane; wv[i] = __builtin_nontemporal_load((const f32x4*)(W + (size_t)(k0 + (f >> 3)) * N + n0 + (f & 7) * 4)); }
#pragma unroll
        for (int i = 0; i < 8; ++i) { const int f = i * 64 + lane; LAS float* d = scr + (f >> 3) * 33 + (f & 7) * 4; d[0] = wv[i].x; d[1] = wv[i].y; d[2] = wv[i].z; d[3] = wv[i].w; }
    }
    asm volatile("s_waitcnt lgkmcnt(0)" ::: "memory");
    const int c = lane & 7;
    f32x4 ga = (f32x4){1.f, 1.f, 1.f, 1.f}, gb = ga;
    if (gain) { ga = *(const f32x4*)(gain + k0 + 8 * c); gb = *(const f32x4*)(gain + k0 + 8 * c + 4); }
#pragma unroll
    for (int j = 0; j < 4; ++j) { const int n = (lane >> 3) + 8 * j; const LAS float* s = scr + (8 * c) * 33 + n;
        u32x4 o; o.x = cvtpk(s[0 * 33] * ga.x, s[1 * 33] * ga.y); o.y = cvtpk(s[2 * 33] * ga.z, s[3 * 33] * ga.w); o.z = cvtpk(s[4 * 33] * gb.x, s[5 * 33] * gb.y); o.w = cvtpk(s[6 * 33] * gb.z, s[7 * 33] * gb.w);
        *(u32x4*)(WT + (size_t)(drow + n) * K + k0 + 8 * c) = o; }
    asm volatile("s_waitcnt lgkmcnt(0)" ::: "memory");
}

__device__ __forceinline__ void norm_rows(const float* src, const float* g1, bf16* d1, const float* g2, bf16* d2, int gw, int ngw) {
    const int lane = fresh_tid() & 63;
    for (int m = gw; m < MTOK; m += ngw) {
        const f32x4* xr = (const f32x4*)(src + (size_t)m * DM) + lane;
        f32x4 v[8]; float s = 0.f;
#pragma unroll
        for (int j = 0; j < 8; ++j) { v[j] = xr[64 * j]; s += (v[j].x * v[j].x + v[j].y * v[j].y) + (v[j].z * v[j].z + v[j].w * v[j].w); }
        const float r = 1.0f / sqrtf(wave_sum(s) * (1.0f / DM) + RMS_EPS);
        u32x2* o1 = (u32x2*)(d1 + (size_t)m * DM) + lane;
#pragma unroll
        for (int j = 0; j < 8; ++j) { const f32x4 g = ((const f32x4*)g1)[lane + 64 * j]; u32x2 w; w.x = cvtpk(v[j].x * r * g.x, v[j].y * r * g.y); w.y = cvtpk(v[j].z * r * g.z, v[j].w * r * g.w); o1[64 * j] = w; }
        if (d2) { u32x2* o2 = (u32x2*)(d2 + (size_t)m * DM) + lane;
#pragma unroll
            for (int j = 0; j < 8; ++j) { const f32x4 g = ((const f32x4*)g2)[lane + 64 * j]; u32x2 w; w.x = cvtpk(v[j].x * r * g.x, v[j].y * r * g.y); w.y = cvtpk(v[j].z * r * g.z, v[j].w * r * g.w); o2[64 * j] = w; } }
    }
}
__device__ __forceinline__ void cast_rows(const float* src, bf16* d1, float* ssq, int gw, int ngw) {
    const int lane = fresh_tid() & 63;
    for (int m = gw; m < MTOK; m += ngw) {
        const f32x4* xr = (const f32x4*)(src + (size_t)m * DM) + lane;
        f32x4 v[8]; float s = 0.f;
#pragma unroll
        for (int j = 0; j < 8; ++j) { v[j] = xr[64 * j]; s += (v[j].x * v[j].x + v[j].y * v[j].y) + (v[j].z * v[j].z + v[j].w * v[j].w); }
        s = wave_sum(s);
        u32x2* o1 = (u32x2*)(d1 + (size_t)m * DM) + lane;
#pragma unroll
        for (int j = 0; j < 8; ++j) { u32x2 w; w.x = cvtpk(v[j].x, v[j].y); w.y = cvtpk(v[j].z, v[j].w); o1[64 * j] = w; }
        if (lane < 32) ssq[(size_t)m * 32 + lane] = lane == 0 ? s : 0.f;
    }
}
__device__ __forceinline__ void final_norm(float* io, const float* g1, int gw, int ngw) {
    const int lane = fresh_tid() & 63;
    for (int m = gw; m < MTOK; m += ngw) {
        f32x4* xr = (f32x4*)(io + (size_t)m * DM) + lane;
        f32x4 v[8]; float s = 0.f;
#pragma unroll
        for (int j = 0; j < 8; ++j) { v[j] = xr[64 * j]; s += (v[j].x * v[j].x + v[j].y * v[j].y) + (v[j].z * v[j].z + v[j].w * v[j].w); }
        const float r = 1.0f / sqrtf(wave_sum(s) * (1.0f / DM) + RMS_EPS);
#pragma unroll
        for (int j = 0; j < 8; ++j) { const f32x4 g = ((const f32x4*)g1)[lane + 64 * j]; xr[64 * j] = v[j] * r * g; }
    }
}

__device__ __forceinline__ int kperm(int r) { return (r & 0x13) | ((r & 4) << 1) | ((r & 8) >> 1); }
__device__ __forceinline__ int crow(int r, int hi) { return (r & 3) + 8 * (r >> 2) + 4 * hi; }

namespace dattn {
constexpr int NS = 4, STAGE = 32768, KSUB = 8192, VOFF = 16384;
constexpr int LUT_OFF = NS * STAGE;
constexpr int NUNITS = BATCH * 16 * 64;
#define DA_WAITV(n) asm volatile("s_waitcnt vmcnt(" #n ")" ::: "memory")

__device__ __forceinline__ void unit(int b, int h, int qb, const bf16* __restrict__ Q, const bf16* __restrict__ K, const bf16* __restrict__ VT, bf16* __restrict__ O,
                                     LAS unsigned char* lds, float lam, const float* __restrict__ subg, float outscale) {
    int tid_ = threadIdx.x; asm volatile("" : "+v"(tid_));
    const int tid = tid_, lane = tid & 63, r32 = lane & 31, hi = lane >> 5;
    const int wid = __builtin_amdgcn_readfirstlane(tid >> 6), c = wid & 1, rg = wid >> 1;
    const int Q0 = qb * 128, qw = Q0 + 32 * rg, q = qw + r32;
    const int NT = Q0 / 64 + 2;
    const size_t tok0 = (size_t)b * SEQ;
    const LAS float* lut = (const LAS float*)(lds + LUT_OFF);
    bf16x8 qf[4];
    { const bf16* qp = Q + (tok0 + q) * DM + (2 * h + c) * 64 + 8 * hi;
#pragma unroll
      for (int ks = 0; ks < 4; ++ks) qf[ks] = *(const bf16x8*)(qp + 16 * ks); }
    const int drow = 8 * wid + (lane >> 3), dch = (lane & 7) ^ ((drow >> 1) & 7);
    const int kgo = drow * DM + dch * 8, vgo = drow * 64 + dch * 8;
    const bf16* kgb = K + tok0 * DM + (2 * h) * 64;
    const bf16* vgb = VT + ((size_t)(b * 128) * 2048 + h * 128) * 64;
    const int dpiece = wid * 1024;
#define DA_DMA(t, st) do { const bf16* kb_ = kgb + (size_t)(t) * 64 * DM + kgo; const bf16* vb_ = vgb + (size_t)(t) * 2048 * 64 + vgo; LAS unsigned char* l_ = lds + (st) * STAGE + dpiece; \
        __builtin_amdgcn_global_load_lds((const unsigned*)kb_, (LAS unsigned*)l_, 16, 0, 0); \
        __builtin_amdgcn_global_load_lds((const unsigned*)(kb_ + 64), (LAS unsigned*)(l_ + KSUB), 16, 0, 0); \
        __builtin_amdgcn_global_load_lds((const unsigned*)vb_, (LAS unsigned*)(l_ + VOFF), 16, 0, 0); \
        __builtin_amdgcn_global_load_lds((const unsigned*)(vb_ + 64 * 64), (LAS unsigned*)(l_ + VOFF + 8192), 16, 0, 0); } while (0)
    DA_DMA(0, 0); DA_DMA(1, 1);
#pragma unroll
    for (int ks = 0; ks < 4; ++ks) asm volatile("" : "+v"(qf[ks]));
    f32x16 o[4];
#pragma unroll
    for (int i = 0; i < 4; ++i) o[i] = f32x16{};
    float m = -INFINITY, l = 0.f;
    int koffk[4], voffj[4];
    { const int kr = kperm(r32), swk = (kr >> 1) & 7, swv = (r32 >> 1) & 7;
#pragma unroll
      for (int i = 0; i < 4; ++i) { koffk[i] = c * KSUB + kr * 128 + (((2 * i + hi) ^ swk) << 4); voffj[i] = VOFF + r32 * 128 + (((2 * i + hi) ^ swv) << 4); } }
    f32x16 pA0 = f32x16{}, pA1 = f32x16{}, pB0, pB1;
#define SBAR() __builtin_amdgcn_sched_barrier(0)
#define LDF(p) (*(const LAS bf16x8*)(p))
#define GA(MF, X, B, W, L, H) do { MF; sacc += X[B]; sacc += X[B + 1]; sacc += X[B + 2]; sacc += X[B + 3]; asm volatile("" : "+v"(sacc)); W.L = cvtpk(X[B], X[B + 1]); W.H = cvtpk(X[B + 2], X[B + 3]); asm volatile("" : "+v"(W)); SBAR(); } while (0)
#define GB(MF, X, B) do { MF; X[B] = __builtin_amdgcn_exp2f(X[B] - m); X[B + 1] = __builtin_amdgcn_exp2f(X[B + 1] - m); asm volatile("" : "+v"(X)); SBAR(); } while (0)
#define MF32(a, b, c) __builtin_amdgcn_mfma_f32_32x32x16_bf16(a, b, c, 0, 0, 0)
#define DA_STEP(tt, C0, C1, P0, P1) do { const int t_ = (tt), k0_ = 64 * t_; \
        DA_WAITV(4); __builtin_amdgcn_s_barrier(); \
        { int tn = t_ + 2; tn = tn < NT ? tn : NT - 1; DA_DMA(tn, (t_ + 2) & 3); } \
        const LAS unsigned char* sk_ = lds + (t_ & 3) * STAGE; const LAS unsigned char* sv_ = lds + ((t_ ? t_ - 1 : 0) & 3) * STAGE; \
        bf16x8 kf[8], va[4], vb[4]; u32x4 pw0, pw1, pw2, pw3; \
        _Pragma("unroll") for (int i = 0; i < 8; ++i) kf[i] = LDF(sk_ + koffk[i & 3] + (i >> 2) * 4096); \
        _Pragma("unroll") for (int db = 0; db < 4; ++db) va[db] = LDF(sv_ + voffj[0] + db * 4096); \
        SBAR(); float sacc = 0.f; \
        GA(C0 = MF32(kf[0], qf[0], f32x16{}), P0, 0, pw0, x, y); \
        GA(C1 = MF32(kf[4], qf[0], f32x16{}), P0, 4, pw0, z, w); \
        GA(C0 = MF32(kf[1], qf[1], C0), P0, 8, pw1, x, y); \
        GA(C1 = MF32(kf[5], qf[1], C1), P0, 12, pw1, z, w); \
        _Pragma("unroll") for (int db = 0; db < 4; ++db) vb[db] = LDF(sv_ + voffj[1] + db * 4096); \
        GA(C0 = MF32(kf[2], qf[2], C0), P1, 0, pw2, x, y); \
        GA(C1 = MF32(kf[6], qf[2], C1), P1, 4, pw2, z, w); \
        GA(C0 = MF32(kf[3], qf[3], C0), P1, 8, pw3, x, y); \
        GA(C1 = MF32(kf[7], qf[3], C1), P1, 12, pw3, z, w); \
        l += sacc; \
        if (qw - (k0_ + 63) < 128) { \
            _Pragma("unroll") for (int r = 0; r < 16; ++r) { const int rel = q - (k0_ + 16 * (r >> 3) + 8 * hi + (r & 7)); \
                C0[r] += lut[min(max(rel + 1, 0), 128)]; C1[r] += lut[min(max(rel - 31, 0), 128)]; } } \
        float mx = C0[0]; \
        _Pragma("unroll") for (int r = 1; r < 16; ++r) mx = fmaxf(mx, C0[r]); \
        _Pragma("unroll") for (int r = 0; r < 16; ++r) mx = fmaxf(mx, C1[r]); \
        mx = fmaxf(mx, swap32(mx)); \
        bool resc = false; float alpha = 1.f; \
        if (__any(mx > m + 8.0f)) { const float mnew = fmaxf(m, mx); alpha = __builtin_amdgcn_exp2f(m - mnew); m = mnew; resc = true; } \
        SBAR(); \
        const bf16x8 f0 = __builtin_bit_cast(bf16x8, pw0), f1 = __builtin_bit_cast(bf16x8, pw1), f2 = __builtin_bit_cast(bf16x8, pw2), f3 = __builtin_bit_cast(bf16x8, pw3); \
        bf16x8 vc[4], vd[4]; \
        GB(o[0] = MF32(va[0], f0, o[0]), C0, 0); \
        _Pragma("unroll") for (int db = 0; db < 4; ++db) vc[db] = LDF(sv_ + voffj[2] + db * 4096); \
        GB(o[1] = MF32(va[1], f0, o[1]), C0, 2); GB(o[2] = MF32(va[2], f0, o[2]), C0, 4); GB(o[3] = MF32(va[3], f0, o[3]), C0, 6); \
        GB(o[0] = MF32(vb[0], f1, o[0]), C0, 8); \
        _Pragma("unroll") for (int db = 0; db < 4; ++db) vd[db] = LDF(sv_ + voffj[3] + db * 4096); \
        GB(o[1] = MF32(vb[1], f1, o[1]), C0, 10); GB(o[2] = MF32(vb[2], f1, o[2]), C0, 12); GB(o[3] = MF32(vb[3], f1, o[3]), C0, 14); \
        GB(o[0] = MF32(vc[0], f2, o[0]), C1, 0); GB(o[1] = MF32(vc[1], f2, o[1]), C1, 2); GB(o[2] = MF32(vc[2], f2, o[2]), C1, 4); GB(o[3] = MF32(vc[3], f2, o[3]), C1, 6); \
        GB(o[0] = MF32(vd[0], f3, o[0]), C1, 8); GB(o[1] = MF32(vd[1], f3, o[1]), C1, 10); GB(o[2] = MF32(vd[2], f3, o[2]), C1, 12); GB(o[3] = MF32(vd[3], f3, o[3]), C1, 14); \
        if (resc) { _Pragma("unroll") for (int i = 0; i < 4; ++i) o[i] *= alpha; l *= alpha; } \
    } while (0)
    for (int t = 0; t < NT; t += 2) {
        DA_STEP(t, pB0, pB1, pA0, pA1);
        DA_STEP(t + 1, pA0, pA1, pB0, pB1);
    }
    {
        const LAS unsigned char* sv_ = lds + ((NT - 1) & 3) * STAGE;
        float sacc = 0.f; u32x4 pw[4];
#pragma unroll
        for (int r = 0; r < 16; ++r) sacc += pA0[r];
#pragma unroll
        for (int r = 0; r < 16; ++r) sacc += pA1[r];
        l += sacc;
#pragma unroll
        for (int j = 0; j < 2; ++j) { pw[j] = (u32x4){cvtpk(pA0[8 * j], pA0[8 * j + 1]), cvtpk(pA0[8 * j + 2], pA0[8 * j + 3]), cvtpk(pA0[8 * j + 4], pA0[8 * j + 5]), cvtpk(pA0[8 * j + 6], pA0[8 * j + 7])};
            pw[2 + j] = (u32x4){cvtpk(pA1[8 * j], pA1[8 * j + 1]), cvtpk(pA1[8 * j + 2], pA1[8 * j + 3]), cvtpk(pA1[8 * j + 4], pA1[8 * j + 5]), cvtpk(pA1[8 * j + 6], pA1[8 * j + 7])}; }
#pragma unroll
        for (int j = 0; j < 4; ++j) { const bf16x8 f = __builtin_bit_cast(bf16x8, pw[j]);
#pragma unroll
            for (int db = 0; db < 4; ++db) o[db] = MF32(LDF(sv_ + voffj[j] + db * 4096), f, o[db]); }
    }
#undef DA_STEP
#undef GA
#undef GB
#undef MF32
#undef LDF
#undef SBAR
#undef DA_DMA
    DA_WAITV(0);
    __syncthreads();
    l += swap32(l);
    const float inv = 1.0f / l;
    LAS float* comb = (LAS float*)lds;
    if (c == 1) {
#pragma unroll
        for (int db = 0; db < 4; ++db)
#pragma unroll
            for (int r = 0; r < 16; ++r) comb[((rg * 4 + db) * 16 + r) * 64 + lane] = o[db][r] * inv;
    }
    __syncthreads();
    if (c == 0) {
        float ss = 0.f;
#pragma unroll
        for (int db = 0; db < 4; ++db)
#pragma unroll
            for (int r = 0; r < 16; ++r) { const float y = o[db][r] * inv - lam * comb[((rg * 4 + db) * 16 + r) * 64 + lane]; o[db][r] = y; ss += y * y; }
        ss += swap32(ss);
        const float rs = 1.0f / sqrtf(ss * (1.0f / 128.0f) + RMS_EPS);
        bf16* op = O + (tok0 + q) * DM + h * 128 + 4 * hi;
        const LAS float* gl = (const LAS float*)(lds + LUT_OFF + 1024);
#pragma unroll
        for (int db = 0; db < 4; ++db)
#pragma unroll
            for (int j = 0; j < 4; ++j) { const f32x4 g = *(const LAS f32x4*)(gl + 32 * db + 8 * j + 4 * hi);
                u32x2 w; w.x = cvtpk(o[db][4 * j + 0] * rs * g.x, o[db][4 * j + 1] * rs * g.y); w.y = cvtpk(o[db][4 * j + 2] * rs * g.z, o[db][4 * j + 3] * rs * g.w);
                *(u32x2*)(op + 32 * db + 8 * j) = w; }
    }
    __syncthreads();
}
}

namespace sbattn {
constexpr int NUNITS = BATCH * 16 * 256;
__device__ __forceinline__ void unit(int b, int h, int qblk, const bf16* __restrict__ Q, const bf16* __restrict__ K, const bf16* __restrict__ VT, bf16* __restrict__ O, LAS unsigned char* wl) {
    int tid_ = threadIdx.x; asm volatile("" : "+v"(tid_));
    const int lane = tid_ & 63, r32 = lane & 31, hi = lane >> 5;
    const size_t tok0 = (size_t)b * SEQ;
    const int q = qblk * 32 + r32;
    bf16x8 qf[8];
    { const bf16* qp = Q + (tok0 + q) * DM + h * 128 + 8 * hi;
#pragma unroll
      for (int ks = 0; ks < 8; ++ks) qf[ks] = *(const bf16x8*)(qp + 16 * ks);
#pragma unroll
      for (int ks = 0; ks < 8; ++ks) asm volatile("" : "+v"(qf[ks])); }
    f32x16 o[4];
#pragma unroll
    for (int i = 0; i < 4; ++i) o[i] = f32x16{};
    float carry = 0.f;
    const int kkey = lane >> 4, kch = lane & 15, vd = lane >> 2, vch = lane & 3;
    const bf16* kg = K + (tok0 + kkey) * DM + h * 128 + kch * 8;
    const bf16* vg = VT + ((size_t)(b * 128) * 2048 + h * 128 + vd) * 64 + vch * 8;
    const int kr = kperm(r32);
    int kro[8], vro[2];
#pragma unroll
    for (int ks = 0; ks < 8; ++ks) kro[ks] = kr * 256 + (((2 * ks + hi) ^ (kr & 15)) << 4);
#pragma unroll
    for (int s = 0; s < 2; ++s) vro[s] = 8192 + r32 * 64 + (((2 * s + hi) ^ ((r32 >> 2) & 3)) << 4);
    for (int kt = qblk; kt >= 0; --kt) {
        const int k0 = kt * 32;
        u32x4 kraw[8], vraw[8];
        { const bf16* kp = kg + (size_t)k0 * DM; const bf16* vp = vg + (size_t)(k0 >> 6) * 2048 * 64 + (k0 & 63);
#pragma unroll
          for (int i = 0; i < 8; ++i) kraw[i] = *(const u32x4*)(kp + (size_t)(4 * i) * DM);
#pragma unroll
          for (int i = 0; i < 8; ++i) vraw[i] = *(const u32x4*)(vp + (16 * i) * 64); }
#pragma unroll
        for (int i = 0; i < 8; ++i) { const int key = 4 * i + kkey; *(LAS u32x4*)(wl + key * 256 + ((kch ^ (key & 15)) << 4)) = kraw[i]; }
#pragma unroll
        for (int i = 0; i < 8; ++i) { const int d = 16 * i + vd; *(LAS u32x4*)(wl + 8192 + d * 64 + ((vch ^ ((d >> 2) & 3)) << 4)) = vraw[i]; }
        f32x16 z = f32x16{};
        { bf16x8 kf[8];
#pragma unroll
          for (int ks = 0; ks < 8; ++ks) kf[ks] = *(const LAS bf16x8*)(wl + kro[ks]);
#pragma unroll
          for (int ks = 0; ks < 8; ++ks) z = __builtin_amdgcn_mfma_f32_32x32x16_bf16(kf[ks], qf[ks], z, 0, 0, 0); }
        bf16x8 vf[4][2];
#pragma unroll
        for (int db = 0; db < 4; ++db)
#pragma unroll
            for (int s = 0; s < 2; ++s) vf[db][s] = *(const LAS bf16x8*)(wl + vro[s] + db * 32 * 64);
        float L[16], lz[16];
        float A0 = 0.f, A1 = 0.f;
#pragma unroll
        for (int r = 0; r < 16; ++r) {
            const int key = k0 + 16 * (r >> 3) + 8 * hi + (r & 7);
            const float zz = z[r];
            const float sp = fmaxf(zz, 0.f) + LN2 * __builtin_amdgcn_logf(1.0f + __builtin_amdgcn_exp2f(-LOG2E * fabsf(zz)));
            const bool valid = key < q;
            L[r] = valid ? -sp : 0.f;
            lz[r] = valid ? (zz - sp) : -INFINITY;
            if (r < 8) A0 += L[r]; else A1 += L[r];
        }
        const float B0 = swap32(A0), B1 = swap32(A1);
        const float base0 = hi ? (B1 + A1) : (B0 + A1 + B1);
        const float base1 = hi ? 0.f : B1;
        float a[16];
        { float run = base0 + carry;
#pragma unroll
          for (int i = 7; i >= 0; --i) { a[i] = __builtin_amdgcn_exp2f(LOG2E * (lz[i] + run)); run += L[i]; }
          run = base1 + carry;
#pragma unroll
          for (int i = 15; i >= 8; --i) { a[i] = __builtin_amdgcn_exp2f(LOG2E * (lz[i] + run)); run += L[i]; } }
        carry += (A0 + A1) + (B0 + B1);
        bf16x8 pf[2];
#pragma unroll
        for (int s = 0; s < 2; ++s) { u32x4 w; w.x = cvtpk(a[8 * s + 0], a[8 * s + 1]); w.y = cvtpk(a[8 * s + 2], a[8 * s + 3]); w.z = cvtpk(a[8 * s + 4], a[8 * s + 5]); w.w = cvtpk(a[8 * s + 6], a[8 * s + 7]); pf[s] = __builtin_bit_cast(bf16x8, w); }
#pragma unroll
        for (int db = 0; db < 4; ++db)
#pragma unroll
            for (int s = 0; s < 2; ++s) o[db] = __builtin_amdgcn_mfma_f32_32x32x16_bf16(vf[db][s], pf[s], o[db], 0, 0, 0);
        if (__all(carry < -105.0f)) break;
    }
    bf16* op = O + (tok0 + q) * DM + h * 128 + 4 * hi;
#pragma unroll
    for (int db = 0; db < 4; ++db)
#pragma unroll
        for (int j = 0; j < 4; ++j) { u32x2 w; w.x = cvtpk(o[db][4 * j + 0], o[db][4 * j + 1]); w.y = cvtpk(o[db][4 * j + 2], o[db][4 * j + 3]); *(u32x2*)(op + 32 * db + 8 * j) = w; }
}
}

#define XB_TMO      128
#define XB_XCNT(j)  (256  + 64 * (j))
#define XB_XSUB(j)  (1280 + 64 * (j))
#define XB_XGEN(j)  (2304 + 64 * (j))
#define XB_TOP      3328
#define XB_TOPGEN   3392
#define XCD_BAR_WORDS 3456
#define XB_SPIN_CAP (1u << 18)

__device__ __forceinline__ unsigned xb_ld(unsigned* p)              { return __hip_atomic_load(p, __ATOMIC_RELAXED, __HIP_MEMORY_SCOPE_AGENT); }
__device__ __forceinline__ unsigned xb_add(unsigned* p, unsigned v) { return __hip_atomic_fetch_add(p, v, __ATOMIC_RELAXED, __HIP_MEMORY_SCOPE_AGENT); }
__device__ __forceinline__ unsigned xb_xcc_id() { return (unsigned)__builtin_amdgcn_s_getreg((3 << 11) | 20) & 0xFu; }
#define XB_SPIN(cond, bar) do { unsigned _sp = 0; while (cond) { __builtin_amdgcn_s_sleep(1); \
    if ((++_sp & 255u) == 0u) { if (xb_ld(&(bar)[XB_TMO])) break; if (_sp > XB_SPIN_CAP) { atomicAdd(&(bar)[XB_TMO], 1u); break; } } } } while (0)

struct XcdBarrier {
    unsigned* bar; unsigned x;
    volatile LAS unsigned* st;
};

__device__ __forceinline__ XcdBarrier xcd_barrier_post(unsigned* bar, volatile LAS unsigned* st) {
    XcdBarrier b; b.bar = bar; b.x = xb_xcc_id(); b.st = st;
    if (threadIdx.x == 0) (void)xb_add(&bar[XB_XCNT(b.x)], 1u);
    return b;
}
__device__ __forceinline__ void xcd_barrier_complete(unsigned* bar, unsigned x, unsigned& nloc, unsigned& nx) {
    const unsigned G = gridDim.x * gridDim.y * gridDim.z;
    unsigned sum, cnt, mine, sp = 0u;
    for (;;) {
        sum = 0u; cnt = 0u; mine = 0u;
#pragma unroll
        for (unsigned j = 0; j < 16; ++j) { const unsigned c = xb_ld(&bar[XB_XCNT(j)]); sum += c; cnt += (c > 0u) ? 1u : 0u; mine = (j == x) ? c : mine; }
        if (sum == G) break;
        __builtin_amdgcn_s_sleep(1);
        if ((++sp & 255u) == 0u) { if (xb_ld(&bar[XB_TMO])) break; if (sp > XB_SPIN_CAP) { atomicAdd(&bar[XB_TMO], 1u); break; } }
    }
    nloc = mine > 0u ? mine : 1u; nx = cnt > 0u ? cnt : 1u;
}

__device__ __forceinline__ void xcd_barrier(const XcdBarrier& b) {
    asm volatile("s_waitcnt vmcnt(0)" ::: "memory");
    __syncthreads();
    if (threadIdx.x == 0) {
        unsigned* bar = b.bar;
        __builtin_amdgcn_s_waitcnt(0);
        unsigned nloc = b.st[0], nx = b.st[1];
        if (nloc == 0u) { xcd_barrier_complete(bar, b.x, nloc, nx); b.st[0] = nloc; b.st[1] = nx; }
        const unsigned old = xb_add(&bar[XB_XSUB(b.x)], 1u);
        const unsigned gen = old / nloc;
        if (old + 1u == (gen + 1u) * nloc) {
            __builtin_amdgcn_fence(__ATOMIC_RELEASE, "agent");
            asm volatile("s_waitcnt vmcnt(0)" ::: "memory");
            const unsigned og = xb_add(&bar[XB_TOP], 1u);
            const unsigned tg = og / nx;
            if (og + 1u == (tg + 1u) * nx) xb_add(&bar[XB_TOPGEN], 1u);
            else XB_SPIN(xb_ld(&bar[XB_TOPGEN]) == tg, bar);
            __builtin_amdgcn_fence(__ATOMIC_ACQUIRE, "agent");
            xb_add(&bar[XB_XGEN(b.x)], 1u);
            asm volatile("s_waitcnt vmcnt(0)" ::: "memory");
        } else {
            XB_SPIN(xb_ld(&bar[XB_XGEN(b.x)]) == gen, bar);
            __builtin_amdgcn_fence(__ATOMIC_ACQUIRE, "agent");
            asm volatile("s_waitcnt vmcnt(0)" ::: "memory");
        }
    }
    __syncthreads();
}

struct Args {
    const float* x; const float* rel_bias; const float* attn_g; const float* ffn_g; const float* w_qkv; const float* w_o;
    const float* lq1; const float* lk1; const float* lq2; const float* lk2; const float* subln_g; const float* kv_g;
    const float* w_kv; const float* w_sq; const float* w_so; const float* w_gate; const float* w_up; const float* w_down; const float* final_g;
    float* out; unsigned char* ws;
};

__global__ void __launch_bounds__(NTHREADS, 2) yoco_fwd(Args a) {
    extern __shared__ __attribute__((aligned(16))) unsigned char lds_raw[];
    cg::grid_group grid = cg::this_grid();
    LAS unsigned char* lds = (LAS unsigned char*)lds_raw;
    const int wave = __builtin_amdgcn_readfirstlane(threadIdx.x >> 6);
    const int G = gridDim.x, bx = blockIdx.x;
    const int gw = bx * NWAVES + wave, ngw = G * NWAVES;
    unsigned char* ws = a.ws;
    volatile LAS unsigned* xb_st = (volatile LAS unsigned*)(lds + 131072 + 15360);
    if (threadIdx.x < 2) xb_st[threadIdx.x] = 0u;
    __syncthreads();
    const XcdBarrier xbar = xcd_barrier_post((unsigned*)(ws + 4096), xb_st);
    bf16* Wqkv_t = (bf16*)(ws + WS_WQKV); bf16* Wo_t = (bf16*)(ws + WS_WO); bf16* Wkv_t = (bf16*)(ws + WS_WKV); bf16* Wsq_t = (bf16*)(ws + WS_WSQ); bf16* Wso_t = (bf16*)(ws + WS_WSO);
    bf16* Wgu_t = (bf16*)(ws + WS_WGU); bf16* Wd_t = (bf16*)(ws + WS_WD);
    bf16* XN = (bf16*)(ws + WS_XN); bf16* QB = (bf16*)(ws + WS_BIG); bf16* KB = QB + (size_t)MTOK * DM; bf16* VTB = KB + (size_t)MTOK * DM; bf16* MID = QB;
    bf16* KS = (bf16*)(ws + WS_KS); bf16* VTS = (bf16*)(ws + WS_VTS); bf16* XH = (bf16*)(ws + WS_XH);
    LAS float* RT = (LAS float*)(lds + 131072);
    float* SSQ = (float*)(ws + WS_SSQ);

    {
        LAS float* scr = (LAS float*)(lds + wave * 16384);
        const int lane = fresh_tid() & 63;
        constexpr int I_QKV = 32 * 192, I_SQ = 32 * 64, I_KV = 32 * 128, I_G = 32 * 176, I_D = 88 * 64;
        constexpr int NITEMS = 2 * I_QKV + 2 * I_SQ + I_KV + 4 * I_SQ + 4 * (2 * I_G + I_D);
        for (int it = gw; it < NITEMS; it += ngw) {
            int r = it;
            if (r < 2 * I_QKV) { const int l = r / I_QKV; transpose_item(a.w_qkv + (size_t)l * DM * 6144, DM, 6144, Wqkv_t + (size_t)l * 6144 * DM, 0, scr, r % I_QKV, lane, a.attn_g + l * DM); continue; } r -= 2 * I_QKV;
            if (r < 2 * I_SQ) { const int l = r / I_SQ; transpose_item(a.w_o + (size_t)l * DM * DM, DM, DM, Wo_t + (size_t)l * DM * DM, 0, scr, r % I_SQ, lane); continue; } r -= 2 * I_SQ;
            if (r < I_KV) { transpose_item(a.w_kv, DM, 4096, Wkv_t, 0, scr, r, lane, a.kv_g); continue; } r -= I_KV;
            if (r < 2 * I_SQ) { const int l = r / I_SQ; transpose_item(a.w_sq + (size_t)l * DM * DM, DM, DM, Wsq_t + (size_t)l * DM * DM, 0, scr, r % I_SQ, lane, a.attn_g + (2 + l) * DM); continue; } r -= 2 * I_SQ;
            if (r < 2 * I_SQ) { const int l = r / I_SQ; transpose_item(a.w_so + (size_t)l * DM * DM, DM, DM, Wso_t + (size_t)l * DM * DM, 0, scr, r % I_SQ, lane); continue; } r -= 2 * I_SQ;
            if (r < 4 * I_G) { const int l = r / I_G; transpose_item(a.w_gate + (size_t)l * DM * FF, DM, FF, Wgu_t + (size_t)l * 2 * FF * DM, 1, scr, r % I_G, lane, a.ffn_g + l * DM); continue; } r -= 4 * I_G;
            if (r < 4 * I_G) { const int l = r / I_G; transpose_item(a.w_up + (size_t)l * DM * FF, DM, FF, Wgu_t + (size_t)l * 2 * FF * DM, 2, scr, r % I_G, lane, a.ffn_g + l * DM); continue; } r -= 4 * I_G;
            { const int l = r / I_D; transpose_item(a.w_down + (size_t)l * FF * DM, FF, DM, Wd_t + (size_t)l * DM * FF, 0, scr, r % I_D, lane); }
        }
        cast_rows(a.x, XH, SSQ, gw, ngw);
    }
    grid.sync();

    for (int l = 0; l < 4; ++l) {
        const bool diff = l < 2;
        const float* hsrc = (l == 0) ? a.x : a.out;
        const float* ssq_a = SSQ + (size_t)(2 * l) * MTOK * 32;
        float* ssq_f = SSQ + (size_t)(2 * l + 1) * MTOK * 32;
        float* ssq_n = SSQ + (size_t)(2 * l + 2) * MTOK * 32;
        {
            pg8::Gemm g{XH, diff ? Wqkv_t + (size_t)l * 6144 * DM : Wsq_t + (size_t)(l - 2) * DM * DM, MTOK, diff ? 4096 : 2048, DM};
            pg8::StaticOrder S; S.init(g.M, g.N, G, bx);
            pg8::build_rtab<false>(RT, ssq_a, S);
            pg8::EpiBf16 E{QB, DM, 2048, (size_t)MTOK * DM, diff ? 0.125f * LOG2E : 0.08838834764831845f, RT};
            pg8::gemm_phase<pg8::EpiBf16, pg8::StaticOrder, true, true>(lds, g, S, E);
        }
        if (diff || l == 2) {
            pg8::Gemm g{diff ? Wqkv_t + (size_t)l * 6144 * DM + (size_t)4096 * DM : Wkv_t + (size_t)2048 * DM, XH, DM, MTOK, DM};
            pg8::StaticOrder S; S.init(g.M, g.N, G, bx);
            pg8::build_rtab<true>(RT, ssq_a, S);
            pg8::EpiVT E{diff ? VTB : VTS, RT};
            pg8::gemm_phase<pg8::EpiVT, pg8::StaticOrder, true, true>(lds, g, S, E);
        }
        if (l == 2) {
            pg8::Gemm g{XH, Wkv_t, MTOK, DM, DM};
            pg8::StaticOrder S; S.init(g.M, g.N, G, bx);
            pg8::build_rtab<false>(RT, ssq_a, S);
            pg8::EpiBf16 E{KS, DM, 0, 0, 1.f, RT};
            pg8::gemm_phase<pg8::EpiBf16, pg8::StaticOrder, true, true>(lds, g, S, E);
        }
        xcd_barrier(xbar);
        if (diff) {
            const float lam_init = (l == 0) ? 0.2f : 0.35550906759f;
            float lam;
            const int tid = fresh_tid(), lane = tid & 63;
            { const float p1 = a.lq1[l * 64 + lane] * a.lk1[l * 64 + lane], p2 = a.lq2[l * 64 + lane] * a.lk2[l * 64 + lane];
              lam = expf(wave_sum(p1)) - expf(wave_sum(p2)) + lam_init; }
            int curh = -1;
            if (tid < 128) ((LAS float*)(lds + dattn::LUT_OFF + 1024))[tid] = a.subln_g[l * 128 + tid] * (1.0f - lam_init);
            for (int i = 0;; ++i) {
                const int pos = i * G + ((i & 1) ? (G - 1 - bx) : bx);
                if (pos >= dattn::NUNITS) break;
                const int qb = 63 - pos / 32, bh = pos % 32, b = bh >> 4, h = bh & 15;
                if (h != curh) {
                    const int tl = fresh_tid();
                    if (tl < 129) { const int n = tl - 1; int bucket;
                        if (n < 16) bucket = n < 0 ? 0 : n; else { int lg = 16 + (int)(logf((float)n / 16.0f) / 2.0794415416798357f * 16.0f); bucket = lg < 31 ? lg : 31; }
                        const float v = (a.rel_bias[bucket * 16 + h] - a.rel_bias[31 * 16 + h]) * LOG2E;
                        ((LAS float*)(lds + dattn::LUT_OFF))[tl] = (n < 0) ? -INFINITY : v; }
                    curh = h;
                    __syncthreads();
                }
                dattn::unit(b, h, qb, QB, KB, VTB, XN, lds, lam, a.subln_g + l * 128, 1.0f - lam_init);
            }
        } else {
            for (int u = gw; u < sbattn::NUNITS; u += ngw) {
                const int bh = u >> 8, qblk = u & 255;
                sbattn::unit(bh >> 4, bh & 15, qblk, QB, KS, VTS, XN, lds + wave * 16384);
            }
        }
        xcd_barrier(xbar);
        {
            pg8::Gemm g{XN, diff ? Wo_t + (size_t)l * DM * DM : Wso_t + (size_t)(l - 2) * DM * DM, MTOK, DM, DM};
            pg8::StaticOrder S; S.init(g.M, g.N, G, bx);
            pg8::EpiResN E{hsrc, a.out, DM, XH, ssq_f};
            pg8::gemm_phase<pg8::EpiResN, pg8::StaticOrder, true, true>(lds, g, S, E);
        }
        xcd_barrier(xbar);
        {
            pg8::Gemm g{XH, Wgu_t + (size_t)l * 2 * FF * DM, MTOK, 2 * FF, DM};
            pg8::StaticOrder S; S.init(g.M, g.N, G, bx);
            pg8::build_rtab<false>(RT, ssq_f, S);
            pg8::EpiSwiGLU E{MID, FF, RT};
            pg8::gemm_phase<pg8::EpiSwiGLU, pg8::StaticOrder, true, true>(lds, g, S, E);
        }
        xcd_barrier(xbar);
        {
            pg8::Gemm g{MID, Wd_t + (size_t)l * DM * FF, MTOK, DM, FF};
            pg8::StaticOrder S; S.init(g.M, g.N, G, bx);
            pg8::EpiResN E{a.out, a.out, DM, l < 3 ? XH : nullptr, ssq_n};
            pg8::gemm_phase<pg8::EpiResN, pg8::StaticOrder, true, true>(lds, g, S, E);
        }
        xcd_barrier(xbar);
    }
    final_norm(a.out, a.final_g, gw, ngw);
}

extern "C" void kernel_launch(void* const* d_in, const int* in_sizes, int n_in, void* d_out, int out_size, void* d_ws, size_t ws_size, hipStream_t stream) {
    static int grid = 0;
    if (grid == 0) {
        if (n_in != 19 || ws_size < WS_END) { fprintf(stderr, "kernel_launch: unexpected inputs (%d) or workspace (%zu < %zu)\n", n_in, ws_size, (size_t)WS_END); grid = -1; return; }
        int dev = 0, cus = 0, per_cu = 0;
        hipGetDevice(&dev); hipDeviceGetAttribute(&cus, hipDeviceAttributeMultiprocessorCount, dev);
        hipFuncSetAttribute((const void*)yoco_fwd, hipFuncAttributeMaxDynamicSharedMemorySize, LDS_BYTES);
        hipOccupancyMaxActiveBlocksPerMultiprocessor(&per_cu, (const void*)yoco_fwd, NTHREADS, LDS_BYTES);
        (void)hipGetLastError();
        if (per_cu < 1) per_cu = 1;
        grid = cus * per_cu;
    }
    if (grid < 0) return;
    Args a{};
    a.x = (const float*)d_in[0]; a.rel_bias = (const float*)d_in[1]; a.attn_g = (const float*)d_in[2]; a.ffn_g = (const float*)d_in[3]; a.w_qkv = (const float*)d_in[4]; a.w_o = (const float*)d_in[5];
    a.lq1 = (const float*)d_in[6]; a.lk1 = (const float*)d_in[7]; a.lq2 = (const float*)d_in[8]; a.lk2 = (const float*)d_in[9]; a.subln_g = (const float*)d_in[10]; a.kv_g = (const float*)d_in[11];
    a.w_kv = (const float*)d_in[12]; a.w_sq = (const float*)d_in[13]; a.w_so = (const float*)d_in[14]; a.w_gate = (const float*)d_in[15]; a.w_up = (const float*)d_in[16]; a.w_down = (const float*)d_in[17]; a.final_g = (const float*)d_in[18];
    a.out = (float*)d_out; a.ws = (unsigned char*)d_ws;
    hipMemsetAsync((char*)d_ws + 4096, 0, XCD_BAR_WORDS * 4, stream);
    void* args[] = {&a};
    hipError_t e = hipLaunchCooperativeKernel((const void*)yoco_fwd, dim3(grid), dim3(NTHREADS), args, LDS_BYTES, stream);
    if (e != hipSuccess) fprintf(stderr, "cooperative launch failed: %s (grid %d)\n", hipGetErrorString(e), grid);
}
```

```cpp
#include <hip/hip_runtime.h>
#include <hip/hip_cooperative_groups.h>
#include <cstdio>
#include <cstdint>
#include <cmath>
namespace cg = cooperative_groups;
namespace pg8 {
#define PG8_LAS __attribute__((address_space(3)))
typedef unsigned short bf16_t;
typedef short bf16x8 __attribute__((ext_vector_type(8)));
typedef float f32x4 __attribute__((ext_vector_type(4)));
typedef unsigned u32x4 __attribute__((ext_vector_type(4)));
constexpr int BM = 256, BK = 64, HALF = 128, HTB = HALF * BK * 2  , STAGE_BYTES = 8 * HTB, NXCD = 8, WGM = 8;

__host__ __device__ __forceinline__ int lds_byte(int r, int c) { const int st = (r >> 4) * 2 + (c >> 5), rr = r & 15, cc = c & 31, ob = rr * 64 + cc * 2; return st * 1024 + (ob ^ (((ob >> 9) & 1) << 5)); }
__host__ __device__ __forceinline__ void stage_rc(int b, int& R, int& C) { const int st = b / 1024, sb = b % 1024, swz = sb ^ (((sb >> 9) & 1) << 5); R = (st >> 1) * 16 + swz / 64; C = (st & 1) * 32 + (swz % 64) / 2; }
__host__ __device__ __forceinline__ int perm32(int rho) { const int n = rho >> 4, i = rho & 15; return 8 * (i >> 2) + 4 * n + (i & 3); }

struct Unit { int pm, pn; const unsigned short* A = nullptr; const unsigned short* Bt = nullptr; int id = 0; };
struct Gemm { const bf16_t* A; const bf16_t* Bt; int M, N, K; };

struct StaticOrder {
    int nM, nN, nwg, G, c;
    __host__ __device__ void init(int M, int N, int G_, int c_) { nM = M / BM; nN = N / BM; nwg = nM * nN; G = G_; c = c_; }
    __host__ __device__ bool next(int i, Unit& u) const {
        const long L = (long)i * G + c; if (L >= nwg) return false;
        int wgid = (int)L; { const int q = nwg / NXCD, r = nwg % NXCD, xcd = wgid % NXCD, off = wgid / NXCD; wgid = (xcd < r ? xcd * (q + 1) : r * (q + 1) + (xcd - r) * q) + off; }
        const int nig = WGM * nN, gid = wgid / nig, fm = gid * WGM, gsz = (nM - fm) < WGM ? (nM - fm) : WGM;
        u.pm = fm + ((wgid % nig) % gsz); u.pn = (wgid % nig) / gsz; return true;
    }
    __device__ __forceinline__ void a_ready(const Unit&) const {}
    __device__ __forceinline__ void done(const Unit&) const {}
};

__device__ __forceinline__ unsigned cvt_pk_bf16(float lo, float hi) { unsigned r; asm volatile("v_cvt_pk_bf16_f32 %0, %1, %2" : "=v"(r) : "v"(lo), "v"(hi)); return r; }
typedef float f32x2 __attribute__((ext_vector_type(2)));

typedef unsigned u32x2e __attribute__((ext_vector_type(2)));
__device__ __forceinline__ float row_rs(const float* part, int row) {
    const f32x4* p = (const f32x4*)(part + (size_t)row * 32); f32x4 s = p[0];
#pragma unroll
    for (int i = 1; i < 8; ++i) s += p[i];
    return __builtin_amdgcn_rsqf(((s[0] + s[1]) + (s[2] + s[3])) * (1.0f / 2048.0f) + 1e-5f);
}


template <bool COLS, class Sched> __device__ __forceinline__ void build_rtab(PG8_LAS float* tab, const float* part, const Sched& S) {
    int t_ = threadIdx.x; asm volatile("" : "+v"(t_));
    Unit u;
    for (int i = 0; i < 14 && S.next(i, u); ++i) { const int base = ((COLS || u.id == 1) ? u.pn : u.pm) * BM; if (t_ < 256) tab[i * 256 + t_] = row_rs(part, base + t_); }
    __syncthreads();
}
struct EpiBf16 {
    static constexpr bool PERM = true, AFTER_DRAIN = false;
    bf16_t* O; int ldc; int split_cols; size_t split_stride; float scale0; const PG8_LAS float* rtab;
    __device__ __forceinline__ void operator()(const f32x4 (&acc)[2][2][4][2], const Unit& u, int ui, int wr, int wc, int fr, int fq) const {
        const int row0 = u.pm * BM + wr * 64 + fr; int colt = u.pn * BM; bf16_t* base = O;
        float sc = 1.f; if (split_cols) { const int t = colt / split_cols; base += (size_t)t * split_stride; colt -= t * split_cols; if (t == 0) sc = scale0; }
        const int col0 = colt + wc * 32 + 8 * fq;
#pragma unroll
        for (int ai = 0; ai < 2; ++ai)
#pragma unroll
            for (int m = 0; m < 4; ++m) { bf16_t* rowp = base + (size_t)(row0 + ai * HALF + m * 16) * ldc + col0;
                const float rsc = sc * rtab[ui * 256 + wr * 64 + fr + ai * HALF + m * 16];
#pragma unroll
                for (int bj = 0; bj < 2; ++bj) { f32x4 v0 = acc[ai][bj][m][0] * rsc, v1 = acc[ai][bj][m][1] * rsc;
                    u32x4 w; w.x = cvt_pk_bf16(v0[0], v0[1]); w.y = cvt_pk_bf16(v0[2], v0[3]); w.z = cvt_pk_bf16(v1[0], v1[1]); w.w = cvt_pk_bf16(v1[2], v1[3]);
                    *(u32x4*)(rowp + bj * HALF) = w; } }
    }
};
struct EpiRes {
    static constexpr bool PERM = false, AFTER_DRAIN = false;
    const float* base; float* out; int ldc;
    __device__ __forceinline__ void operator()(const f32x4 (&acc)[2][2][4][2], const Unit& u, int ui, int wr, int wc, int fr, int fq) const {
        const int col0 = u.pn * BM + wc * 32 + 4 * fq;
#pragma unroll
        for (int ai = 0; ai < 2; ++ai)
#pragma unroll
            for (int m = 0; m < 4; ++m) { const size_t off = (size_t)(u.pm * BM + ai * HALF + wr * 64 + m * 16 + fr) * ldc + col0;
#pragma unroll
                for (int bj = 0; bj < 2; ++bj)
#pragma unroll
                    for (int n = 0; n < 2; ++n) { const f32x4 bs = *(const f32x4*)(base + off + bj * HALF + n * 16); *(f32x4*)(out + off + bj * HALF + n * 16) = bs + acc[ai][bj][m][n]; } }
    }
};
struct EpiSwiGLU {
    static constexpr bool PERM = true, AFTER_DRAIN = false;
    bf16_t* O; int ldc; const PG8_LAS float* rtab;
    __device__ __forceinline__ static float silu_mul(float g, float u) { return g * u * __builtin_amdgcn_rcpf(1.0f + __builtin_amdgcn_exp2f(-1.4426950408889634f * g)); }
    __device__ __forceinline__ void operator()(const f32x4 (&acc)[2][2][4][2], const Unit& u, int ui, int wr, int wc, int fr, int fq) const {
        const int row0 = u.pm * BM + wr * 64 + fr; const int col0 = u.pn * HALF + wc * 32 + 8 * fq;
#pragma unroll
        for (int ai = 0; ai < 2; ++ai)
#pragma unroll
            for (int m = 0; m < 4; ++m) { bf16_t* rowp = O + (size_t)(row0 + ai * HALF + m * 16) * ldc + col0;
                const float rsc = rtab[ui * 256 + wr * 64 + fr + ai * HALF + m * 16];
                const f32x4 g0 = acc[ai][0][m][0] * rsc, g1 = acc[ai][0][m][1] * rsc, u0 = acc[ai][1][m][0] * rsc, u1 = acc[ai][1][m][1] * rsc;
                u32x4 w; w.x = cvt_pk_bf16(silu_mul(g0[0], u0[0]), silu_mul(g0[1], u0[1])); w.y = cvt_pk_bf16(silu_mul(g0[2], u0[2]), silu_mul(g0[3], u0[3]));
                w.z = cvt_pk_bf16(silu_mul(g1[0], u1[0]), silu_mul(g1[1], u1[1])); w.w = cvt_pk_bf16(silu_mul(g1[2], u1[2]), silu_mul(g1[3], u1[3]));
                *(u32x4*)rowp = w; }
    }
};

struct EpiVT {
    static constexpr bool PERM = true, AFTER_DRAIN = false;
    bf16_t* O; const PG8_LAS float* rtab;
    __device__ __forceinline__ void operator()(const f32x4 (&acc)[2][2][4][2], const Unit& u, int ui, int wr, int wc, int fr, int fq) const {
        const int row0 = u.pm * BM + wr * 64 + fr; const int col0 = u.pn * BM + wc * 32 + 8 * fq;
        f32x4 cs[2][2];
#pragma unroll
        for (int bj = 0; bj < 2; ++bj)
#pragma unroll
            for (int n = 0; n < 2; ++n) cs[bj][n] = *(const PG8_LAS f32x4*)(rtab + ui * 256 + wc * 32 + 8 * fq + bj * HALF + 4 * n);
#pragma unroll
        for (int ai = 0; ai < 2; ++ai)
#pragma unroll
            for (int m = 0; m < 4; ++m) { const int ch = row0 + ai * HALF + m * 16;
#pragma unroll
                for (int bj = 0; bj < 2; ++bj) { const int col = col0 + bj * HALF; const f32x4 v0 = acc[ai][bj][m][0] * cs[bj][0], v1 = acc[ai][bj][m][1] * cs[bj][1];
                    u32x4 w; w.x = cvt_pk_bf16(v0[0], v0[1]); w.y = cvt_pk_bf16(v0[2], v0[3]); w.z = cvt_pk_bf16(v1[0], v1[1]); w.w = cvt_pk_bf16(v1[2], v1[3]);
                    *(u32x4*)(O + ((size_t)(col >> 6) * 2048 + ch) * 64 + (col & 63)) = w; } }
    }
};

struct EpiResN {
    static constexpr bool PERM = false, AFTER_DRAIN = false;
    const float* base; float* out; int ldc; bf16_t* XH; float* ssq;
    __device__ __forceinline__ void operator()(const f32x4 (&acc)[2][2][4][2], const Unit& u, int ui, int wr, int wc, int fr, int fq) const {
        const int col0 = u.pn * BM + wc * 32 + 4 * fq; const int rowb = u.pm * BM + wr * 64 + fr;
        f32x4 nxt[2][2];
#pragma unroll
        for (int bj = 0; bj < 2; ++bj)
#pragma unroll
            for (int n = 0; n < 2; ++n) nxt[bj][n] = *(const f32x4*)(base + (size_t)rowb * ldc + col0 + bj * HALF + n * 16);
#pragma unroll
        for (int g = 0; g < 8; ++g) { const int ai = g >> 2, m = g & 3; const int row = rowb + ai * HALF + m * 16; const size_t off = (size_t)row * ldc + col0;
            f32x4 cur[2][2];
#pragma unroll
            for (int bj = 0; bj < 2; ++bj)
#pragma unroll
                for (int n = 0; n < 2; ++n) cur[bj][n] = nxt[bj][n];
            if (g + 1 < 8) { const int row2 = rowb + ((g + 1) >> 2) * HALF + ((g + 1) & 3) * 16;
#pragma unroll
                for (int bj = 0; bj < 2; ++bj)
#pragma unroll
                    for (int n = 0; n < 2; ++n) nxt[bj][n] = *(const f32x4*)(base + (size_t)row2 * ldc + col0 + bj * HALF + n * 16); }
            float ss = 0.f;
#pragma unroll
            for (int bj = 0; bj < 2; ++bj)
#pragma unroll
                for (int n = 0; n < 2; ++n) { const f32x4 v = cur[bj][n] + acc[ai][bj][m][n]; *(f32x4*)(out + off + bj * HALF + n * 16) = v;
                    if (XH) { u32x2e w; w.x = cvt_pk_bf16(v[0], v[1]); w.y = cvt_pk_bf16(v[2], v[3]); *(u32x2e*)(XH + off + bj * HALF + n * 16) = w; }
                    ss += (v[0] * v[0] + v[1] * v[1]) + (v[2] * v[2] + v[3] * v[3]); }
            if (XH) {
            ss += __int_as_float(__builtin_amdgcn_ds_swizzle(__float_as_int(ss), (16 << 10) | 0x1f));
            { auto rr = __builtin_amdgcn_permlane32_swap(__float_as_uint(ss), __float_as_uint(ss), false, false); ss = __uint_as_float(rr[0]) + __uint_as_float(rr[1]); }
            if (fq == 0) ssq[(size_t)row * 32 + u.pn * 4 + wc] = ss; } }
    }
};

struct MultiOrder {
    StaticOrder s0, s1, s2; const bf16_t *A0, *B0, *A1, *B1, *A2, *B2; int n0, n1, n2;
    __device__ __forceinline__ static int count(const StaticOrder& s) { return s.nwg > s.c ? (s.nwg - s.c + s.G - 1) / s.G : 0; }
    __device__ __forceinline__ bool next(int i, Unit& u) const {
        if (i < n0) { s0.next(i, u); u.A = A0; u.Bt = B0; u.id = 0; return true; } i -= n0;
        if (i < n1) { s1.next(i, u); u.A = A1; u.Bt = B1; u.id = 1; return true; } i -= n1;
        if (i < n2) { s2.next(i, u); u.A = A2; u.Bt = B2; u.id = 2; return true; }
        return false;
    }
    __device__ __forceinline__ void a_ready(const Unit&) const {}
    __device__ __forceinline__ void done(const Unit&) const {}
};
struct EpiMulti {
    static constexpr bool PERM = true, AFTER_DRAIN = false;
    EpiBf16 e0; EpiVT e1; EpiBf16 e2;
    __device__ __forceinline__ void operator()(const f32x4 (&acc)[2][2][4][2], const Unit& u, int ui, int wr, int wc, int fr, int fq) const {
        if (u.id == 0) e0(acc, u, ui, wr, wc, fr, fq); else if (u.id == 1) e1(acc, u, ui, wr, wc, fr, fq); else e2(acc, u, ui, wr, wc, fr, fq);
    }
};

template <class Epi, class Sched, bool ALIGN_EPI = false, bool SP2 = false>
__device__ __forceinline__ void gemm_phase(PG8_LAS unsigned char* lds, const Gemm g, const Sched& S, const Epi& E) {
    int tid_ = threadIdx.x; asm volatile("" : "+v"(tid_));
    const int tid = tid_, wid = __builtin_amdgcn_readfirstlane(tid >> 6), lane = tid & 63, wr = wid >> 2, wc = wid & 3, fr = lane & 15, fq = lane >> 4;
    const int K = g.K, nt = K / BK;
    unsigned voffA[2], voffB[2];
#pragma unroll
    for (int i = 0; i < 2; ++i) { int R, C; stage_rc(tid * 16 + i * 8192, R, C); const int Rb = Epi::PERM ? ((R & ~31) + perm32(R & 31)) : R;
        voffA[i] = (unsigned)(R * K + C) * 2u; voffB[i] = (unsigned)(Rb * K + C) * 2u; }
    const size_t kstep = (size_t)(BK * 2);
    const size_t hstep = (size_t)HALF * K * 2;
    const size_t tstep = 2 * hstep;
    const unsigned ldsw = (unsigned)wid * 1024u;
    const int aoff = lds_byte(wr * 64 + fr, fq * 8), boff = lds_byte(wc * 32 + fr, fq * 8);
#define PG8_SA(b, h) (((b) * 2 + (h)) * HTB)
#define PG8_SB(b, h) ((4 + (b) * 2 + (h)) * HTB)
#define PG8_STAGE(bufoff, gbase, voff) do { _Pragma("unroll") for (int _i = 0; _i < 2; ++_i) \
        __builtin_amdgcn_global_load_lds((const unsigned*)((const char*)(gbase) + (voff)[_i]), (PG8_LAS unsigned*)(lds + (bufoff) + ldsw + _i * 8192), 16, 0, 0); } while (0)
#define PG8_LDA(dst, b, h) do { _Pragma("unroll") for (int m = 0; m < 4; ++m) _Pragma("unroll") for (int k = 0; k < 2; ++k) dst[m][k] = *(const PG8_LAS bf16x8*)(lds + PG8_SA(b, h) + aoff + m * 2048 + k * 1024); } while (0)
#define PG8_LDB(dst, b, h) do { _Pragma("unroll") for (int n = 0; n < 2; ++n) _Pragma("unroll") for (int k = 0; k < 2; ++k) dst[n][k] = *(const PG8_LAS bf16x8*)(lds + PG8_SB(b, h) + boff + n * 2048 + k * 1024); } while (0)
#define PG8_MMA(ai, bj, At, Bt) do { __builtin_amdgcn_s_setprio(1); _Pragma("unroll") for (int m = 0; m < 4; ++m) _Pragma("unroll") for (int n = 0; n < 2; ++n) _Pragma("unroll") for (int k = 0; k < 2; ++k) \
        acc[ai][bj][m][n] = __builtin_amdgcn_mfma_f32_16x16x32_bf16(Bt[n][k], At[m][k], acc[ai][bj][m][n], 0, 0, 0); __builtin_amdgcn_s_setprio(0); } while (0)
#define PG8_WAIT_V(n) asm volatile("s_waitcnt vmcnt(" #n ")" ::: "memory")
#define PG8_WAIT_L(n) asm volatile("s_waitcnt lgkmcnt(" #n ")" ::: "memory")
#define PG8_BAR __builtin_amdgcn_s_barrier()
#define PG8_SCHED __builtin_amdgcn_sched_barrier(0)
    Unit cur, nxt; int ui = 0;
    if (!S.next(0, cur)) return;
    f32x4 acc[2][2][4][2];
#pragma unroll
    for (int a = 0; a < 2; ++a)
#pragma unroll
        for (int b = 0; b < 2; ++b)
#pragma unroll
            for (int m = 0; m < 4; ++m)
#pragma unroll
                for (int n = 0; n < 2; ++n) acc[a][b][m][n] = (f32x4){0.f, 0.f, 0.f, 0.f};
    bf16x8 At[4][2], B0[2][2], B1[2][2];
    const char* cA = (const char*)(cur.A ? cur.A : g.A) + (size_t)cur.pm * tstep; const char* cB = (const char*)(cur.Bt ? cur.Bt : g.Bt) + (size_t)cur.pn * tstep;
    S.a_ready(cur);
    if constexpr (SP2) {
        PG8_STAGE(PG8_SB(0, 0), cB, voffB); PG8_STAGE(PG8_SB(0, 1), cB + hstep, voffB); PG8_STAGE(PG8_SA(0, 0), cA, voffA); PG8_STAGE(PG8_SA(0, 1), cA + hstep, voffA);
        if (wr == 1) PG8_BAR;
        PG8_WAIT_V(2); PG8_BAR;
        PG8_STAGE(PG8_SB(1, 0), cB + kstep, voffB); PG8_STAGE(PG8_SA(1, 0), cA + kstep, voffA); PG8_STAGE(PG8_SB(1, 1), cB + hstep + kstep, voffB);
        PG8_WAIT_V(6); PG8_BAR;
    } else {
        PG8_STAGE(PG8_SB(0, 0), cB, voffB); PG8_STAGE(PG8_SA(0, 0), cA, voffA); PG8_STAGE(PG8_SB(0, 1), cB + hstep, voffB); PG8_STAGE(PG8_SA(0, 1), cA + hstep, voffA);
        if (wr == 1) PG8_BAR;
        PG8_WAIT_V(4); PG8_BAR;
        PG8_STAGE(PG8_SB(1, 0), cB + kstep, voffB); PG8_STAGE(PG8_SA(1, 0), cA + kstep, voffA); PG8_STAGE(PG8_SB(1, 1), cB + hstep + kstep, voffB);
        PG8_WAIT_V(6); PG8_BAR;
    }
    for (;;) {
        const bool has_next = S.next(ui + 1, nxt);
        const char* nA = has_next ? (const char*)(nxt.A ? nxt.A : g.A) + (size_t)nxt.pm * tstep : cA; const char* nB = has_next ? (const char*)(nxt.Bt ? nxt.Bt : g.Bt) + (size_t)nxt.pn * tstep : cB;
        for (int t = 0; t < nt; t += 2) {
            const bool last = (t == nt - 2);
            const char* a1 = cA + (size_t)(t + 1) * kstep;
            const char* a2 = last ? nA : cA + (size_t)(t + 2) * kstep; const char* b2 = last ? nB : cB + (size_t)(t + 2) * kstep;
            const char* a3 = a2 + kstep; const char* b3 = b2 + kstep;
            if (last && has_next) S.a_ready(nxt);
            if constexpr (SP2) {
            PG8_LDB(B0, 0, 0); PG8_LDB(B1, 0, 1); PG8_SCHED; PG8_LDA(At, 0, 0); PG8_STAGE(PG8_SA(1, 1), a1 + hstep, voffA);
            PG8_WAIT_V(8); PG8_WAIT_L(0); PG8_BAR; PG8_MMA(0, 0, At, B0); PG8_MMA(0, 1, At, B1); PG8_BAR; PG8_SCHED;
            PG8_LDA(At, 0, 1); PG8_STAGE(PG8_SB(0, 0), b2, voffB); PG8_STAGE(PG8_SB(0, 1), b2 + hstep, voffB); PG8_STAGE(PG8_SA(0, 0), a2, voffA);
            PG8_WAIT_V(8); PG8_WAIT_L(0); PG8_BAR; PG8_MMA(1, 0, At, B0); PG8_MMA(1, 1, At, B1); PG8_BAR; PG8_SCHED;
            PG8_LDB(B0, 1, 0); PG8_LDB(B1, 1, 1); PG8_SCHED; PG8_LDA(At, 1, 0); PG8_STAGE(PG8_SA(0, 1), a2 + hstep, voffA);
            PG8_WAIT_V(8); PG8_WAIT_L(0); PG8_BAR; PG8_MMA(0, 0, At, B0); PG8_MMA(0, 1, At, B1); PG8_BAR; PG8_SCHED;
            PG8_LDA(At, 1, 1); PG8_STAGE(PG8_SB(1, 0), b3, voffB); PG8_STAGE(PG8_SB(1, 1), b3 + hstep, voffB); PG8_STAGE(PG8_SA(1, 0), a3, voffA);
            PG8_WAIT_V(8); PG8_WAIT_L(0); PG8_BAR; PG8_MMA(1, 0, At, B0); PG8_MMA(1, 1, At, B1); PG8_BAR; PG8_SCHED;
            } else {
            PG8_LDB(B0, 0, 0); PG8_SCHED; PG8_LDA(At, 0, 0); PG8_STAGE(PG8_SA(1, 1), a1 + hstep, voffA);
            PG8_WAIT_L(8); PG8_BAR; PG8_WAIT_L(0); PG8_MMA(0, 0, At, B0); PG8_BAR; PG8_SCHED;
            PG8_LDB(B1, 0, 1); PG8_STAGE(PG8_SB(0, 0), b2, voffB);
            PG8_BAR; PG8_WAIT_L(0); PG8_MMA(0, 1, At, B1); PG8_BAR;
            PG8_LDA(At, 0, 1); PG8_STAGE(PG8_SA(0, 0), a2, voffA);
            PG8_BAR; PG8_WAIT_L(0); PG8_MMA(1, 0, At, B0); PG8_BAR; PG8_SCHED;
            PG8_STAGE(PG8_SB(0, 1), b2 + hstep, voffB);
            PG8_WAIT_V(6); PG8_BAR; PG8_MMA(1, 1, At, B1); PG8_BAR;
            PG8_LDB(B0, 1, 0); PG8_SCHED; PG8_LDA(At, 1, 0); PG8_STAGE(PG8_SA(0, 1), a2 + hstep, voffA);
            PG8_WAIT_L(8); PG8_BAR; PG8_WAIT_L(0); PG8_MMA(0, 0, At, B0); PG8_BAR; PG8_SCHED;
            PG8_LDB(B1, 1, 1); PG8_STAGE(PG8_SB(1, 0), b3, voffB);
            PG8_BAR; PG8_WAIT_L(0); PG8_MMA(0, 1, At, B1); PG8_BAR;
            PG8_LDA(At, 1, 1); PG8_STAGE(PG8_SA(1, 0), a3, voffA);
            PG8_BAR; PG8_WAIT_L(0); PG8_MMA(1, 0, At, B0); PG8_BAR; PG8_SCHED;
            PG8_STAGE(PG8_SB(1, 1), b3 + hstep, voffB);
            PG8_WAIT_V(6); PG8_BAR; PG8_MMA(1, 1, At, B1); PG8_BAR;
            }
        }
        if constexpr (ALIGN_EPI) { if (wr == 0) PG8_BAR; }
        if constexpr (!Epi::AFTER_DRAIN) { E(acc, cur, ui, wr, wc, fr, fq); S.done(cur); }
        if (!has_next) break;
#pragma unroll
        for (int a = 0; a < 2; ++a)
#pragma unroll
            for (int b = 0; b < 2; ++b)
#pragma unroll
                for (int m = 0; m < 4; ++m)
#pragma unroll
                    for (int n = 0; n < 2; ++n) acc[a][b][m][n] = (f32x4){0.f, 0.f, 0.f, 0.f};
        cur = nxt; cA = nA; cB = nB; ++ui;
        if constexpr (ALIGN_EPI) { if (wr == 1) PG8_BAR; }
    }
    PG8_WAIT_V(0);
    if constexpr (!ALIGN_EPI) { if (wr == 0) PG8_BAR; }
    PG8_BAR;
    if constexpr (Epi::AFTER_DRAIN) { E.fused(acc, cur, wr, wc, fr, fq, lds, wid, lane); S.done(cur); }
#undef PG8_SA
#undef PG8_SB
#undef PG8_STAGE
#undef PG8_LDA
#undef PG8_LDB
#undef PG8_MMA
#undef PG8_WAIT_V
#undef PG8_WAIT_L
#undef PG8_BAR
#undef PG8_SCHED
}
}

#define LAS __attribute__((address_space(3)))
typedef unsigned short bf16;
typedef short bf16x8 __attribute__((ext_vector_type(8)));
typedef float f32x4 __attribute__((ext_vector_type(4)));
typedef float f32x16 __attribute__((ext_vector_type(16)));
typedef unsigned u32x4 __attribute__((ext_vector_type(4)));
typedef unsigned u32x2 __attribute__((ext_vector_type(2)));

constexpr int NWAVES = 8, NTHREADS = 512;
constexpr int BATCH = 2, SEQ = 8192, DM = 2048, FF = 5632, MTOK = BATCH * SEQ;
constexpr float RMS_EPS = 1e-5f;
constexpr float LOG2E = 1.4426950408889634f, LN2 = 0.6931471805599453f;
constexpr int LDS_BYTES = 147456;

constexpr size_t MiB = 1u << 20;
constexpr size_t WS_WQKV = 2 * MiB;
constexpr size_t WS_WO   = WS_WQKV + 48 * MiB;
constexpr size_t WS_WKV  = WS_WO + 16 * MiB;
constexpr size_t WS_WSQ  = WS_WKV + 16 * MiB;
constexpr size_t WS_WSO  = WS_WSQ + 16 * MiB;
constexpr size_t WS_WGU  = WS_WSO + 16 * MiB;
constexpr size_t WS_WD   = WS_WGU + 176 * MiB;
constexpr size_t WS_XN   = WS_WD + 88 * MiB;
constexpr size_t WS_BIG  = WS_XN + 64 * MiB;
constexpr size_t WS_KS   = WS_BIG + 192 * MiB;
constexpr size_t WS_VTS  = WS_KS + 64 * MiB;
constexpr size_t WS_XH   = WS_VTS + 64 * MiB;
constexpr size_t WS_SSQ  = WS_XH + 64 * MiB;
constexpr size_t WS_END  = WS_SSQ + 18 * MiB;

__device__ __forceinline__ int fresh_tid() { int t = threadIdx.x; asm volatile("" : "+v"(t)); return t; }
#define SWZ_XOR(v, k) __int_as_float(__builtin_amdgcn_ds_swizzle(__float_as_int(v), ((k) << 10) | 0x1f))
__device__ __forceinline__ float wave_sum(float v) {
    v += SWZ_XOR(v, 1); v += SWZ_XOR(v, 2); v += SWZ_XOR(v, 4); v += SWZ_XOR(v, 8); v += SWZ_XOR(v, 16);
    auto rr = __builtin_amdgcn_permlane32_swap(__float_as_uint(v), __float_as_uint(v), false, false);
    return __uint_as_float(rr[0]) + __uint_as_float(rr[1]);
}
__device__ __forceinline__ unsigned cvtpk(float lo, float hi) { unsigned r; asm volatile("v_cvt_pk_bf16_f32 %0, %1, %2" : "=v"(r) : "v"(lo), "v"(hi)); return r; }
__device__ __forceinline__ float swap32(float v) {
    auto rr = __builtin_amdgcn_permlane32_swap(__float_as_uint(v), __float_as_uint(v), false, false);
    return (threadIdx.x & 32) ? __uint_as_float(rr[0]) : __uint_as_float(rr[1]);
}

__device__ __forceinline__ void transpose_item(const float* W, int K, int N, bf16* WT, int mode, LAS float* scr, int item, int lane, const float* gain = nullptr) {
    const int nblk = N / 32, kb = item / nblk, nb = item % nblk, k0 = 64 * kb, n0 = 32 * nb;
    int drow = n0;
    if (mode == 1) drow = 256 * (n0 >> 7) + (n0 & 127);
    if (mode == 2) drow = 256 * (n0 >> 7) + 128 + (n0 & 127);
    {
        f32x4 wv[8];
#pragma unroll
        for (int i = 0; i < 8; ++i) { const int f = i * 64 + lane; wv[i] = __builtin_nontemporal_load((const f32x4*)(W + (size_t)(k0 + (f >> 3)) * N + n0 + (f & 7) * 4)); }
#pragma unroll
        for (int i = 0; i < 8; ++i) { const int f = i * 64 + lane; LAS float* d = scr + (f >> 3) * 33 + (f & 7) * 4; d[0] = wv[i].x; d[1] = wv[i].y; d[2] = wv[i].z; d[3] = wv[i].w; }
    }
    asm volatile("s_waitcnt lgkmcnt(0)" ::: "memory");
    const int c = lane & 7;
    f32x4 ga = (f32x4){1.f, 1.f, 1.f, 1.f}, gb = ga;
    if (gain) { ga = *(const f32x4*)(gain + k0 + 8 * c); gb = *(const f32x4*)(gain + k0 + 8 * c + 4); }
#pragma unroll
    for (int j = 0; j < 4; ++j) { const int n = (lane >> 3) + 8 * j; const LAS float* s = scr + (8 * c) * 33 + n;
        u32x4 o; o.x = cvtpk(s[0 * 33] * ga.x, s[1 * 33] * ga.y); o.y = cvtpk(s[2 * 33] * ga.z, s[3 * 33] * ga.w); o.z = cvtpk(s[4 * 33] * gb.x, s[5 * 33] * gb.y); o.w = cvtpk(s[6 * 33] * gb.z, s[7 * 33] * gb.w);
        *(u32x4*)(WT + (size_t)(drow + n) * K + k0 + 8 * c) = o; }
    asm volatile("s_waitcnt lgkmcnt(0)" ::: "memory");
}

__device__ __forceinline__ void norm_rows(const float* src, const float* g1, bf16* d1, const float* g2, bf16* d2, int gw, int ngw) {
    const int lane = fresh_tid() & 63;
    for (int m = gw; m < MTOK; m += ngw) {
        const f32x4* xr = (const f32x4*)(src + (size_t)m * DM) + lane;
        f32x4 v[8]; float s = 0.f;
#pragma unroll
        for (int j = 0; j < 8; ++j) { v[j] = xr[64 * j]; s += (v[j].x * v[j].x + v[j].y * v[j].y) + (v[j].z * v[j].z + v[j].w * v[j].w); }
        const float r = 1.0f / sqrtf(wave_sum(s) * (1.0f / DM) + RMS_EPS);
        u32x2* o1 = (u32x2*)(d1 + (size_t)m * DM) + lane;
#pragma unroll
        for (int j = 0; j < 8; ++j) { const f32x4 g = ((const f32x4*)g1)[lane + 64 * j]; u32x2 w; w.x = cvtpk(v[j].x * r * g.x, v[j].y * r * g.y); w.y = cvtpk(v[j].z * r * g.z, v[j].w * r * g.w); o1[64 * j] = w; }
        if (d2) { u32x2* o2 = (u32x2*)(d2 + (size_t)m * DM) + lane;
#pragma unroll
            for (int j = 0; j < 8; ++j) { const f32x4 g = ((const f32x4*)g2)[lane + 64 * j]; u32x2 w; w.x = cvtpk(v[j].x * r * g.x, v[j].y * r * g.y); w.y = cvtpk(v[j].z * r * g.z, v[j].w * r * g.w); o2[64 * j] = w; } }
    }
}
__device__ __forceinline__ void cast_rows(const float* src, bf16* d1, float* ssq, int gw, int ngw) {
    const int lane = fresh_tid() & 63;
    for (int m = gw; m < MTOK; m += ngw) {
        const f32x4* xr = (const f32x4*)(src + (size_t)m * DM) + lane;
        f32x4 v[8]; float s = 0.f;
#pragma unroll
        for (int j = 0; j < 8; ++j) { v[j] = xr[64 * j]; s += (v[j].x * v[j].x + v[j].y * v[j].y) + (v[j].z * v[j].z + v[j].w * v[j].w); }
        s = wave_sum(s);
        u32x2* o1 = (u32x2*)(d1 + (size_t)m * DM) + lane;
#pragma unroll
        for (int j = 0; j < 8; ++j) { u32x2 w; w.x = cvtpk(v[j].x, v[j].y); w.y = cvtpk(v[j].z, v[j].w); o1[64 * j] = w; }
        if (lane < 32) ssq[(size_t)m * 32 + lane] = lane == 0 ? s : 0.f;
    }
}
__device__ __forceinline__ void final_norm(float* io, const float* g1, int gw, int ngw) {
    const int lane = fresh_tid() & 63;
    for (int m = gw; m < MTOK; m += ngw) {
        f32x4* xr = (f32x4*)(io + (size_t)m * DM) + lane;
        f32x4 v[8]; float s = 0.f;
#pragma unroll
        for (int j = 0; j < 8; ++j) { v[j] = xr[64 * j]; s += (v[j].x * v[j].x + v[j].y * v[j].y) + (v[j].z * v[j].z + v[j].w * v[j].w); }
        const float r = 1.0f / sqrtf(wave_sum(s) * (1.0f / DM) + RMS_EPS);
#pragma unroll
        for (int j = 0; j < 8; ++j) { const f32x4 g = ((const f32x4*)g1)[lane + 64 * j]; xr[64 * j] = v[j] * r * g; }
    }
}

__device__ __forceinline__ int kperm(int r) { return (r & 0x13) | ((r & 4) << 1) | ((r & 8) >> 1); }
__device__ __forceinline__ int crow(int r, int hi) { return (r & 3) + 8 * (r >> 2) + 4 * hi; }

namespace dattn {
constexpr int NS = 4, STAGE = 32768, KSUB = 8192, VOFF = 16384;
constexpr int LUT_OFF = NS * STAGE;
constexpr int NUNITS = BATCH * 16 * 64;
#define DA_WAITV(n) asm volatile("s_waitcnt vmcnt(" #n ")" ::: "memory")

__device__ __forceinline__ void unit(int b, int h, int qb, const bf16* __restrict__ Q, const bf16* __restrict__ K, const bf16* __restrict__ VT, bf16* __restrict__ O,
                                     LAS unsigned char* lds, float lam, const float* __restrict__ subg, float outscale) {
    int tid_ = threadIdx.x; asm volatile("" : "+v"(tid_));
    const int tid = tid_, lane = tid & 63, r32 = lane & 31, hi = lane >> 5;
    const int wid = __builtin_amdgcn_readfirstlane(tid >> 6), c = wid & 1, rg = wid >> 1;
    const int Q0 = qb * 128, qw = Q0 + 32 * rg, q = qw + r32;
    const int NT = Q0 / 64 + 2;
    const size_t tok0 = (size_t)b * SEQ;
    const LAS float* lut = (const LAS float*)(lds + LUT_OFF);
    bf16x8 qf[4];
    { const bf16* qp = Q + (tok0 + q) * DM + (2 * h + c) * 64 + 8 * hi;
#pragma unroll
      for (int ks = 0; ks < 4; ++ks) qf[ks] = *(const bf16x8*)(qp + 16 * ks); }
    const int drow = 8 * wid + (lane >> 3), dch = (lane & 7) ^ ((drow >> 1) & 7);
    const int kgo = drow * DM + dch * 8, vgo = drow * 64 + dch * 8;
    const bf16* kgb = K + tok0 * DM + (2 * h) * 64;
    const bf16* vgb = VT + ((size_t)(b * 128) * 2048 + h * 128) * 64;
    const int dpiece = wid * 1024;
#define DA_DMA(t, st) do { const bf16* kb_ = kgb + (size_t)(t) * 64 * DM + kgo; const bf16* vb_ = vgb + (size_t)(t) * 2048 * 64 + vgo; LAS unsigned char* l_ = lds + (st) * STAGE + dpiece; \
        __builtin_amdgcn_global_load_lds((const unsigned*)kb_, (LAS unsigned*)l_, 16, 0, 0); \
        __builtin_amdgcn_global_load_lds((const unsigned*)(kb_ + 64), (LAS unsigned*)(l_ + KSUB), 16, 0, 0); \
        __builtin_amdgcn_global_load_lds((const unsigned*)vb_, (LAS unsigned*)(l_ + VOFF), 16, 0, 0); \
        __builtin_amdgcn_global_load_lds((const unsigned*)(vb_ + 64 * 64), (LAS unsigned*)(l_ + VOFF + 8192), 16, 0, 0); } while (0)
    DA_DMA(0, 0); DA_DMA(1, 1);
#pragma unroll
    for (int ks = 0; ks < 4; ++ks) asm volatile("" : "+v"(qf[ks]));
    f32x16 o[4];
#pragma unroll
    for (int i = 0; i < 4; ++i) o[i] = f32x16{};
    float m = -INFINITY, l = 0.f;
    int koffk[4], voffj[4];
    { const int kr = kperm(r32), swk = (kr >> 1) & 7, swv = (r32 >> 1) & 7;
#pragma unroll
      for (int i = 0; i < 4; ++i) { koffk[i] = c * KSUB + kr * 128 + (((2 * i + hi) ^ swk) << 4); voffj[i] = VOFF + r32 * 128 + (((2 * i + hi) ^ swv) << 4); } }
    f32x16 pA0 = f32x16{}, pA1 = f32x16{}, pB0, pB1;
#define SBAR() __builtin_amdgcn_sched_barrier(0)
#define LDF(p) (*(const LAS bf16x8*)(p))
#define GA(MF, X, B, W, L, H) do { MF; sacc += X[B]; sacc += X[B + 1]; sacc += X[B + 2]; sacc += X[B + 3]; asm volatile("" : "+v"(sacc)); W.L = cvtpk(X[B], X[B + 1]); W.H = cvtpk(X[B + 2], X[B + 3]); asm volatile("" : "+v"(W)); SBAR(); } while (0)
#define GB(MF, X, B) do { MF; X[B] = __builtin_amdgcn_exp2f(X[B] - m); X[B + 1] = __builtin_amdgcn_exp2f(X[B + 1] - m); asm volatile("" : "+v"(X)); SBAR(); } while (0)
#define MF32(a, b, c) __builtin_amdgcn_mfma_f32_32x32x16_bf16(a, b, c, 0, 0, 0)
#define DA_STEP(tt, C0, C1, P0, P1) do { const int t_ = (tt), k0_ = 64 * t_; \
        DA_WAITV(4); __builtin_amdgcn_s_barrier(); \
        { int tn = t_ + 2; tn = tn < NT ? tn : NT - 1; DA_DMA(tn, (t_ + 2) & 3); } \
        const LAS unsigned char* sk_ = lds + (t_ & 3) * STAGE; const LAS unsigned char* sv_ = lds + ((t_ ? t_ - 1 : 0) & 3) * STAGE; \
        bf16x8 kf[8], va[4], vb[4]; u32x4 pw0, pw1, pw2, pw3; \
        _Pragma("unroll") for (int i = 0; i < 8; ++i) kf[i] = LDF(sk_ + koffk[i & 3] + (i >> 2) * 4096); \
        _Pragma("unroll") for (int db = 0; db < 4; ++db) va[db] = LDF(sv_ + voffj[0] + db * 4096); \
        SBAR(); float sacc = 0.f; \
        GA(C0 = MF32(kf[0], qf[0], f32x16{}), P0, 0, pw0, x, y); \
        GA(C1 = MF32(kf[4], qf[0], f32x16{}), P0, 4, pw0, z, w); \
        GA(C0 = MF32(kf[1], qf[1], C0), P0, 8, pw1, x, y); \
        GA(C1 = MF32(kf[5], qf[1], C1), P0, 12, pw1, z, w); \
        _Pragma("unroll") for (int db = 0; db < 4; ++db) vb[db] = LDF(sv_ + voffj[1] + db * 4096); \
        GA(C0 = MF32(kf[2], qf[2], C0), P1, 0, pw2, x, y); \
        GA(C1 = MF32(kf[6], qf[2], C1), P1, 4, pw2, z, w); \
        GA(C0 = MF32(kf[3], qf[3], C0), P1, 8, pw3, x, y); \
        GA(C1 = MF32(kf[7], qf[3], C1), P1, 12, pw3, z, w); \
        l += sacc; \
        if (qw - (k0_ + 63) < 128) { \
            _Pragma("unroll") for (int r = 0; r < 16; ++r) { const int rel = q - (k0_ + 16 * (r >> 3) + 8 * hi + (r & 7)); \
                C0[r] += lut[min(max(rel + 1, 0), 128)]; C1[r] += lut[min(max(rel - 31, 0), 128)]; } } \
        float mx = C0[0]; \
        _Pragma("unroll") for (int r = 1; r < 16; ++r) mx = fmaxf(mx, C0[r]); \
        _Pragma("unroll") for (int r = 0; r < 16; ++r) mx = fmaxf(mx, C1[r]); \
        mx = fmaxf(mx, swap32(mx)); \
        bool resc = false; float alpha = 1.f; \
        if (__any(mx > m + 8.0f)) { const float mnew = fmaxf(m, mx); alpha = __builtin_amdgcn_exp2f(m - mnew); m = mnew; resc = true; } \
        SBAR(); \
        const bf16x8 f0 = __builtin_bit_cast(bf16x8, pw0), f1 = __builtin_bit_cast(bf16x8, pw1), f2 = __builtin_bit_cast(bf16x8, pw2), f3 = __builtin_bit_cast(bf16x8, pw3); \
        bf16x8 vc[4], vd[4]; \
        GB(o[0] = MF32(va[0], f0, o[0]), C0, 0); \
        _Pragma("unroll") for (int db = 0; db < 4; ++db) vc[db] = LDF(sv_ + voffj[2] + db * 4096); \
        GB(o[1] = MF32(va[1], f0, o[1]), C0, 2); GB(o[2] = MF32(va[2], f0, o[2]), C0, 4); GB(o[3] = MF32(va[3], f0, o[3]), C0, 6); \
        GB(o[0] = MF32(vb[0], f1, o[0]), C0, 8); \
        _Pragma("unroll") for (int db = 0; db < 4; ++db) vd[db] = LDF(sv_ + voffj[3] + db * 4096); \
        GB(o[1] = MF32(vb[1], f1, o[1]), C0, 10); GB(o[2] = MF32(vb[2], f1, o[2]), C0, 12); GB(o[3] = MF32(vb[3], f1, o[3]), C0, 14); \
        GB(o[0] = MF32(vc[0], f2, o[0]), C1, 0); GB(o[1] = MF32(vc[1], f2, o[1]), C1, 2); GB(o[2] = MF32(vc[2], f2, o[2]), C1, 4); GB(o[3] = MF32(vc[3], f2, o[3]), C1, 6); \
        GB(o[0] = MF32(vd[0], f3, o[0]), C1, 8); GB(o[1] = MF32(vd[1], f3, o[1]), C1, 10); GB(o[2] = MF32(vd[2], f3, o[2]), C1, 12); GB(o[3] = MF32(vd[3], f3, o[3]), C1, 14); \
        if (resc) { _Pragma("unroll") for (int i = 0; i < 4; ++i) o[i] *= alpha; l *= alpha; } \
    } while (0)
    for (int t = 0; t < NT; t += 2) {
        DA_STEP(t, pB0, pB1, pA0, pA1);
        DA_STEP(t + 1, pA0, pA1, pB0, pB1);
    }
    {
        const LAS unsigned char* sv_ = lds + ((NT - 1) & 3) * STAGE;
        float sacc = 0.f; u32x4 pw[4];
#pragma unroll
        for (int r = 0; r < 16; ++r) sacc += pA0[r];
#pragma unroll
        for (int r = 0; r < 16; ++r) sacc += pA1[r];
        l += sacc;
#pragma unroll
        for (int j = 0; j < 2; ++j) { pw[j] = (u32x4){cvtpk(pA0[8 * j], pA0[8 * j + 1]), cvtpk(pA0[8 * j + 2], pA0[8 * j + 3]), cvtpk(pA0[8 * j + 4], pA0[8 * j + 5]), cvtpk(pA0[8 * j + 6], pA0[8 * j + 7])};
            pw[2 + j] = (u32x4){cvtpk(pA1[8 * j], pA1[8 * j + 1]), cvtpk(pA1[8 * j + 2], pA1[8 * j + 3]), cvtpk(pA1[8 * j + 4], pA1[8 * j + 5]), cvtpk(pA1[8 * j + 6], pA1[8 * j + 7])}; }
#pragma unroll
        for (int j = 0; j < 4; ++j) { const bf16x8 f = __builtin_bit_cast(bf16x8, pw[j]);
#pragma unroll
            for (int db = 0; db < 4; ++db) o[db] = MF32(LDF(sv_ + voffj[j] + db * 4096), f, o[db]); }
    }
#undef DA_STEP
#undef GA
#undef GB
#undef MF32
#undef LDF
#undef SBAR
#undef DA_DMA
    DA_WAITV(0);
    __syncthreads();
    l += swap32(l);
    const float inv = 1.0f / l;
    LAS float* comb = (LAS float*)lds;
    if (c == 1) {
#pragma unroll
        for (int db = 0; db < 4; ++db)
#pragma unroll
            for (int r = 0; r < 16; ++r) comb[((rg * 4 + db) * 16 + r) * 64 + lane] = o[db][r] * inv;
    }
    __syncthreads();
    if (c == 0) {
        float ss = 0.f;
#pragma unroll
        for (int db = 0; db < 4; ++db)
#pragma unroll
            for (int r = 0; r < 16; ++r) { const float y = o[db][r] * inv - lam * comb[((rg * 4 + db) * 16 + r) * 64 + lane]; o[db][r] = y; ss += y * y; }
        ss += swap32(ss);
        const float rs = 1.0f / sqrtf(ss * (1.0f / 128.0f) + RMS_EPS);
        bf16* op = O + (tok0 + q) * DM + h * 128 + 4 * hi;
        const LAS float* gl = (const LAS float*)(lds + LUT_OFF + 1024);
#pragma unroll
        for (int db = 0; db < 4; ++db)
#pragma unroll
            for (int j = 0; j < 4; ++j) { const f32x4 g = *(const LAS f32x4*)(gl + 32 * db + 8 * j + 4 * hi);
                u32x2 w; w.x = cvtpk(o[db][4 * j + 0] * rs * g.x, o[db][4 * j + 1] * rs * g.y); w.y = cvtpk(o[db][4 * j + 2] * rs * g.z, o[db][4 * j + 3] * rs * g.w);
                *(u32x2*)(op + 32 * db + 8 * j) = w; }
    }
    __syncthreads();
}
}

namespace sbattn {
constexpr int NUNITS = BATCH * 16 * 256;
__device__ __forceinline__ void unit(int b, int h, int qblk, const bf16* __restrict__ Q, const bf16* __restrict__ K, const bf16* __restrict__ VT, bf16* __restrict__ O, LAS unsigned char* wl) {
    int tid_ = threadIdx.x; asm volatile("" : "+v"(tid_));
    const int lane = tid_ & 63, r32 = lane & 31, hi = lane >> 5;
    const size_t tok0 = (size_t)b * SEQ;
    const int q = qblk * 32 + r32;
    bf16x8 qf[8];
    { const bf16* qp = Q + (tok0 + q) * DM + h * 128 + 8 * hi;
#pragma unroll
      for (int ks = 0; ks < 8; ++ks) qf[ks] = *(const bf16x8*)(qp + 16 * ks);
#pragma unroll
      for (int ks = 0; ks < 8; ++ks) asm volatile("" : "+v"(qf[ks])); }
    f32x16 o[4];
#pragma unroll
    for (int i = 0; i < 4; ++i) o[i] = f32x16{};
    float carry = 0.f;
    const int kkey = lane >> 4, kch = lane & 15, vd = lane >> 2, vch = lane & 3;
    const bf16* kg = K + (tok0 + kkey) * DM + h * 128 + kch * 8;
    const bf16* vg = VT + ((size_t)(b * 128) * 2048 + h * 128 + vd) * 64 + vch * 8;
    const int kr = kperm(r32);
    int kro[8], vro[2];
#pragma unroll
    for (int ks = 0; ks < 8; ++ks) kro[ks] = kr * 256 + (((2 * ks + hi) ^ (kr & 15)) << 4);
#pragma unroll
    for (int s = 0; s < 2; ++s) vro[s] = 8192 + r32 * 64 + (((2 * s + hi) ^ ((r32 >> 2) & 3)) << 4);
    for (int kt = qblk; kt >= 0; --kt) {
        const int k0 = kt * 32;
        u32x4 kraw[8], vraw[8];
        { const bf16* kp = kg + (size_t)k0 * DM; const bf16* vp = vg + (size_t)(k0 >> 6) * 2048 * 64 + (k0 & 63);
#pragma unroll
          for (int i = 0; i < 8; ++i) kraw[i] = *(const u32x4*)(kp + (size_t)(4 * i) * DM);
#pragma unroll
          for (int i = 0; i < 8; ++i) vraw[i] = *(const u32x4*)(vp + (16 * i) * 64); }
#pragma unroll
        for (int i = 0; i < 8; ++i) { const int key = 4 * i + kkey; *(LAS u32x4*)(wl + key * 256 + ((kch ^ (key & 15)) << 4)) = kraw[i]; }
#pragma unroll
        for (int i = 0; i < 8; ++i) { const int d = 16 * i + vd; *(LAS u32x4*)(wl + 8192 + d * 64 + ((vch ^ ((d >> 2) & 3)) << 4)) = vraw[i]; }
        f32x16 z = f32x16{};
        { bf16x8 kf[8];
#pragma unroll
          for (int ks = 0; ks < 8; ++ks) kf[ks] = *(const LAS bf16x8*)(wl + kro[ks]);
#pragma unroll
          for (int ks = 0; ks < 8; ++ks) z = __builtin_amdgcn_mfma_f32_32x32x16_bf16(kf[ks], qf[ks], z, 0, 0, 0); }
        bf16x8 vf[4][2];
#pragma unroll
        for (int db = 0; db < 4; ++db)
#pragma unroll
            for (int s = 0; s < 2; ++s) vf[db][s] = *(const LAS bf16x8*)(wl + vro[s] + db * 32 * 64);
        float L[16], lz[16];
        float A0 = 0.f, A1 = 0.f;
#pragma unroll
        for (int r = 0; r < 16; ++r) {
            const int key = k0 + 16 * (r >> 3) + 8 * hi + (r & 7);
            const float zz = z[r];
            const float sp = fmaxf(zz, 0.f) + LN2 * __builtin_amdgcn_logf(1.0f + __builtin_amdgcn_exp2f(-LOG2E * fabsf(zz)));
            const bool valid = key < q;
            L[r] = valid ? -sp : 0.f;
            lz[r] = valid ? (zz - sp) : -INFINITY;
            if (r < 8) A0 += L[r]; else A1 += L[r];
        }
        const float B0 = swap32(A0), B1 = swap32(A1);
        const float base0 = hi ? (B1 + A1) : (B0 + A1 + B1);
        const float base1 = hi ? 0.f : B1;
        float a[16];
        { float run = base0 + carry;
#pragma unroll
          for (int i = 7; i >= 0; --i) { a[i] = __builtin_amdgcn_exp2f(LOG2E * (lz[i] + run)); run += L[i]; }
          run = base1 + carry;
#pragma unroll
          for (int i = 15; i >= 8; --i) { a[i] = __builtin_amdgcn_exp2f(LOG2E * (lz[i] + run)); run += L[i]; } }
        carry += (A0 + A1) + (B0 + B1);
        bf16x8 pf[2];
#pragma unroll
        for (int s = 0; s < 2; ++s) { u32x4 w; w.x = cvtpk(a[8 * s + 0], a[8 * s + 1]); w.y = cvtpk(a[8 * s + 2], a[8 * s + 3]); w.z = cvtpk(a[8 * s + 4], a[8 * s + 5]); w.w = cvtpk(a[8 * s + 6], a[8 * s + 7]); pf[s] = __builtin_bit_cast(bf16x8, w); }
#pragma unroll
        for (int db = 0; db < 4; ++db)
#pragma unroll
            for (int s = 0; s < 2; ++s) o[db] = __builtin_amdgcn_mfma_f32_32x32x16_bf16(vf[db][s], pf[s], o[db], 0, 0, 0);
        if (__all(carry < -105.0f)) break;
    }
    bf16* op = O + (tok0 + q) * DM + h * 128 + 4 * hi;
#pragma unroll
    for (int db = 0; db < 4; ++db)
#pragma unroll
        for (int j = 0; j < 4; ++j) { u32x2 w; w.x = cvtpk(o[db][4 * j + 0], o[db][4 * j + 1]); w.y = cvtpk(o[db][4 * j + 2], o[db][4 * j + 3]); *(u32x2*)(op + 32 * db + 8 * j) = w; }
}
}

#define XB_TMO      128
#define XB_XCNT(j)  (256  + 64 * (j))
#define XB_XSUB(j)  (1280 + 64 * (j))
#define XB_XGEN(j)  (2304 + 64 * (j))
#define XB_TOP      3328
#define XB_TOPGEN   3392
#define XCD_BAR_WORDS 3456
#define XB_SPIN_CAP (1u << 18)

__device__ __forceinline__ unsigned xb_ld(unsigned* p)              { return __hip_atomic_load(p, __ATOMIC_RELAXED, __HIP_MEMORY_SCOPE_AGENT); }
__device__ __forceinline__ unsigned xb_add(unsigned* p, unsigned v) { return __hip_atomic_fetch_add(p, v, __ATOMIC_RELAXED, __HIP_MEMORY_SCOPE_AGENT); }
__device__ __forceinline__ unsigned xb_xcc_id() { return (unsigned)__builtin_amdgcn_s_getreg((3 << 11) | 20) & 0xFu; }
#define XB_SPIN(cond, bar) do { unsigned _sp = 0; while (cond) { __builtin_amdgcn_s_sleep(1); \
    if ((++_sp & 255u) == 0u) { if (xb_ld(&(bar)[XB_TMO])) break; if (_sp > XB_SPIN_CAP) { atomicAdd(&(bar)[XB_TMO], 1u); break; } } } } while (0)

struct XcdBarrier {
    unsigned* bar; unsigned x;
    volatile LAS unsigned* st;
};

__device__ __forceinline__ XcdBarrier xcd_barrier_post(unsigned* bar, volatile LAS unsigned* st) {
    XcdBarrier b; b.bar = bar; b.x = xb_xcc_id(); b.st = st;
    if (threadIdx.x == 0) (void)xb_add(&bar[XB_XCNT(b.x)], 1u);
    return b;
}
__device__ __forceinline__ void xcd_barrier_complete(unsigned* bar, unsigned x, unsigned& nloc, unsigned& nx) {
    const unsigned G = gridDim.x * gridDim.y * gridDim.z;
    unsigned sum, cnt, mine, sp = 0u;
    for (;;) {
        sum = 0u; cnt = 0u; mine = 0u;
#pragma unroll
        for (unsigned j = 0; j < 16; ++j) { const unsigned c = xb_ld(&bar[XB_XCNT(j)]); sum += c; cnt += (c > 0u) ? 1u : 0u; mine = (j == x) ? c : mine; }
        if (sum == G) break;
        __builtin_amdgcn_s_sleep(1);
        if ((++sp & 255u) == 0u) { if (xb_ld(&bar[XB_TMO])) break; if (sp > XB_SPIN_CAP) { atomicAdd(&bar[XB_TMO], 1u); break; } }
    }
    nloc = mine > 0u ? mine : 1u; nx = cnt > 0u ? cnt : 1u;
}

__device__ __forceinline__ void xcd_barrier(const XcdBarrier& b) {
    asm volatile("s_waitcnt vmcnt(0)" ::: "memory");
    __syncthreads();
    if (threadIdx.x == 0) {
        unsigned* bar = b.bar;
        __builtin_amdgcn_s_waitcnt(0);
        unsigned nloc = b.st[0], nx = b.st[1];
        if (nloc == 0u) { xcd_barrier_complete(bar, b.x, nloc, nx); b.st[0] = nloc; b.st[1] = nx; }
        const unsigned old = xb_add(&bar[XB_XSUB(b.x)], 1u);
        const unsigned gen = old / nloc;
        if (old + 1u == (gen + 1u) * nloc) {
            __builtin_amdgcn_fence(__ATOMIC_RELEASE, "agent");
            asm volatile("s_waitcnt vmcnt(0)" ::: "memory");
            const unsigned og = xb_add(&bar[XB_TOP], 1u);
            const unsigned tg = og / nx;
            if (og + 1u == (tg + 1u) * nx) xb_add(&bar[XB_TOPGEN], 1u);
            else XB_SPIN(xb_ld(&bar[XB_TOPGEN]) == tg, bar);
            __builtin_amdgcn_fence(__ATOMIC_ACQUIRE, "agent");
            xb_add(&bar[XB_XGEN(b.x)], 1u);
            asm volatile("s_waitcnt vmcnt(0)" ::: "memory");
        } else {
            XB_SPIN(xb_ld(&bar[XB_XGEN(b.x)]) == gen, bar);
            __builtin_amdgcn_fence(__ATOMIC_ACQUIRE, "agent");
            asm volatile("s_waitcnt vmcnt(0)" ::: "memory");
        }
    }
    __syncthreads();
}

struct Args {
    const float* x; const float* rel_bias; const float* attn_g; const float* ffn_g; const float* w_qkv; const float* w_o;
    const float* lq1; const float* lk1; const float* lq2; const float* lk2; const float* subln_g; const float* kv_g;
    const float* w_kv; const float* w_sq; const float* w_so; const float* w_gate; const float* w_up; const float* w_down; const float* final_g;
    float* out; unsigned char* ws;
};

__global__ void __launch_bounds__(NTHREADS, 2) yoco_fwd(Args a) {
    extern __shared__ __attribute__((aligned(16))) unsigned char lds_raw[];
    cg::grid_group grid = cg::this_grid();
    LAS unsigned char* lds = (LAS unsigned char*)lds_raw;
    const int wave = __builtin_amdgcn_readfirstlane(threadIdx.x >> 6);
    const int G = gridDim.x, bx = blockIdx.x;
    const int gw = bx * NWAVES + wave, ngw = G * NWAVES;
    unsigned char* ws = a.ws;
    volatile LAS unsigned* xb_st = (volatile LAS unsigned*)(lds + 131072 + 15360);
    if (threadIdx.x < 2) xb_st[threadIdx.x] = 0u;
    __syncthreads();
    const XcdBarrier xbar = xcd_barrier_post((unsigned*)(ws + 4096), xb_st);
    bf16* Wqkv_t = (bf16*)(ws + WS_WQKV); bf16* Wo_t = (bf16*)(ws + WS_WO); bf16* Wkv_t = (bf16*)(ws + WS_WKV); bf16* Wsq_t = (bf16*)(ws + WS_WSQ); bf16* Wso_t = (bf16*)(ws + WS_WSO);
    bf16* Wgu_t = (bf16*)(ws + WS_WGU); bf16* Wd_t = (bf16*)(ws + WS_WD);
    bf16* XN = (bf16*)(ws + WS_XN); bf16* QB = (bf16*)(ws + WS_BIG); bf16* KB = QB + (size_t)MTOK * DM; bf16* VTB = KB + (size_t)MTOK * DM; bf16* MID = QB;
    bf16* KS = (bf16*)(ws + WS_KS); bf16* VTS = (bf16*)(ws + WS_VTS); bf16* XH = (bf16*)(ws + WS_XH);
    LAS float* RT = (LAS float*)(lds + 131072);
    float* SSQ = (float*)(ws + WS_SSQ);

    {
        LAS float* scr = (LAS float*)(lds + wave * 16384);
        const int lane = fresh_tid() & 63;
        constexpr int I_QKV = 32 * 192, I_SQ = 32 * 64, I_KV = 32 * 128, I_G = 32 * 176, I_D = 88 * 64;
        constexpr int NITEMS = 2 * I_QKV + 2 * I_SQ + I_KV + 4 * I_SQ + 4 * (2 * I_G + I_D);
        for (int it = gw; it < NITEMS; it += ngw) {
            int r = it;
            if (r < 2 * I_QKV) { const int l = r / I_QKV; transpose_item(a.w_qkv + (size_t)l * DM * 6144, DM, 6144, Wqkv_t + (size_t)l * 6144 * DM, 0, scr, r % I_QKV, lane, a.attn_g + l * DM); continue; } r -= 2 * I_QKV;
            if (r < 2 * I_SQ) { const int l = r / I_SQ; transpose_item(a.w_o + (size_t)l * DM * DM, DM, DM, Wo_t + (size_t)l * DM * DM, 0, scr, r % I_SQ, lane); continue; } r -= 2 * I_SQ;
            if (r < I_KV) { transpose_item(a.w_kv, DM, 4096, Wkv_t, 0, scr, r, lane, a.kv_g); continue; } r -= I_KV;
            if (r < 2 * I_SQ) { const int l = r / I_SQ; transpose_item(a.w_sq + (size_t)l * DM * DM, DM, DM, Wsq_t + (size_t)l * DM * DM, 0, scr, r % I_SQ, lane, a.attn_g + (2 + l) * DM); continue; } r -= 2 * I_SQ;
            if (r < 2 * I_SQ) { const int l = r / I_SQ; transpose_item(a.w_so + (size_t)l * DM * DM, DM, DM, Wso_t + (size_t)l * DM * DM, 0, scr, r % I_SQ, lane); continue; } r -= 2 * I_SQ;
            if (r < 4 * I_G) { const int l = r / I_G; transpose_item(a.w_gate + (size_t)l * DM * FF, DM, FF, Wgu_t + (size_t)l * 2 * FF * DM, 1, scr, r % I_G, lane, a.ffn_g + l * DM); continue; } r -= 4 * I_G;
            if (r < 4 * I_G) { const int l = r / I_G; transpose_item(a.w_up + (size_t)l * DM * FF, DM, FF, Wgu_t + (size_t)l * 2 * FF * DM, 2, scr, r % I_G, lane, a.ffn_g + l * DM); continue; } r -= 4 * I_G;
            { const int l = r / I_D; transpose_item(a.w_down + (size_t)l * FF * DM, FF, DM, Wd_t + (size_t)l * DM * FF, 0, scr, r % I_D, lane); }
        }
        cast_rows(a.x, XH, SSQ, gw, ngw);
    }
    grid.sync();

    for (int l = 0; l < 4; ++l) {
        const bool diff = l < 2;
        const float* hsrc = (l == 0) ? a.x : a.out;
        const float* ssq_a = SSQ + (size_t)(2 * l) * MTOK * 32;
        float* ssq_f = SSQ + (size_t)(2 * l + 1) * MTOK * 32;
        float* ssq_n = SSQ + (size_t)(2 * l + 2) * MTOK * 32;
        {
            pg8::Gemm g{XH, XH, MTOK, DM, DM};
            pg8::MultiOrder S;
            const bf16* Wp = diff ? Wqkv_t + (size_t)l * 6144 * DM : Wsq_t + (size_t)(l - 2) * DM * DM;
            const bf16* Wv = diff ? Wqkv_t + (size_t)l * 6144 * DM + (size_t)4096 * DM : Wkv_t + (size_t)2048 * DM;
            S.s0.init(MTOK, diff ? 4096 : 2048, G, bx); S.A0 = XH; S.B0 = Wp; S.n0 = pg8::MultiOrder::count(S.s0);
            S.s1.init(DM, MTOK, G, bx); S.A1 = Wv; S.B1 = XH; S.n1 = (diff || l == 2) ? pg8::MultiOrder::count(S.s1) : 0;
            S.s2.init(MTOK, DM, G, bx); S.A2 = XH; S.B2 = Wkv_t; S.n2 = (l == 2) ? pg8::MultiOrder::count(S.s2) : 0;
            pg8::build_rtab<false>(RT, ssq_a, S);
            pg8::EpiMulti E{pg8::EpiBf16{QB, DM, 2048, (size_t)MTOK * DM, diff ? 0.125f * LOG2E : 0.08838834764831845f, RT},
                            pg8::EpiVT{diff ? VTB : VTS, RT},
                            pg8::EpiBf16{KS, DM, 0, 0, 1.f, RT}};
            pg8::gemm_phase<pg8::EpiMulti, pg8::MultiOrder, true, true>(lds, g, S, E);
        }
        xcd_barrier(xbar);
        if (diff) {
            const float lam_init = (l == 0) ? 0.2f : 0.35550906759f;
            float lam;
            const int tid = fresh_tid(), lane = tid & 63;
            { const float p1 = a.lq1[l * 64 + lane] * a.lk1[l * 64 + lane], p2 = a.lq2[l * 64 + lane] * a.lk2[l * 64 + lane];
              lam = expf(wave_sum(p1)) - expf(wave_sum(p2)) + lam_init; }
            int curh = -1;
            if (tid < 128) ((LAS float*)(lds + dattn::LUT_OFF + 1024))[tid] = a.subln_g[l * 128 + tid] * (1.0f - lam_init);
            for (int i = 0;; ++i) {
                const int pos = i * G + ((i & 1) ? (G - 1 - bx) : bx);
                if (pos >= dattn::NUNITS) break;
                const int qb = 63 - pos / 32, bh = pos % 32, b = bh >> 4, h = bh & 15;
                if (h != curh) {
                    const int tl = fresh_tid();
                    if (tl < 129) { const int n = tl - 1; int bucket;
                        if (n < 16) bucket = n < 0 ? 0 : n; else { int lg = 16 + (int)(logf((float)n / 16.0f) / 2.0794415416798357f * 16.0f); bucket = lg < 31 ? lg : 31; }
                        const float v = (a.rel_bias[bucket * 16 + h] - a.rel_bias[31 * 16 + h]) * LOG2E;
                        ((LAS float*)(lds + dattn::LUT_OFF))[tl] = (n < 0) ? -INFINITY : v; }
                    curh = h;
                    __syncthreads();
                }
                dattn::unit(b, h, qb, QB, KB, VTB, XN, lds, lam, a.subln_g + l * 128, 1.0f - lam_init);
            }
        } else {
            for (int u = gw; u < sbattn::NUNITS; u += ngw) {
                const int bh = u >> 8, qblk = u & 255;
                sbattn::unit(bh >> 4, bh & 15, qblk, QB, KS, VTS, XN, lds + wave * 16384);
            }
        }
        xcd_barrier(xbar);
        {
            pg8::Gemm g{XN, diff ? Wo_t + (size_t)l * DM * DM : Wso_t + (size_t)(l - 2) * DM * DM, MTOK, DM, DM};
            pg8::StaticOrder S; S.init(g.M, g.N, G, bx);
            pg8::EpiResN E{hsrc, a.out, DM, XH, ssq_f};
            pg8::gemm_phase<pg8::EpiResN, pg8::StaticOrder, true, true>(lds, g, S, E);
        }
        xcd_barrier(xbar);
        {
            pg8::Gemm g{XH, Wgu_t + (size_t)l * 2 * FF * DM, MTOK, 2 * FF, DM};
            pg8::StaticOrder S; S.init(g.M, g.N, G, bx);
            pg8::build_rtab<false>(RT, ssq_f, S);
            pg8::EpiSwiGLU E{MID, FF, RT};
            pg8::gemm_phase<pg8::EpiSwiGLU, pg8::StaticOrder, true, true>(lds, g, S, E);
        }
        xcd_barrier(xbar);
        {
            pg8::Gemm g{MID, Wd_t + (size_t)l * DM * FF, MTOK, DM, FF};
            pg8::StaticOrder S; S.init(g.M, g.N, G, bx);
            pg8::EpiResN E{a.out, a.out, DM, l < 3 ? XH : nullptr, ssq_n};
            pg8::gemm_phase<pg8::EpiResN, pg8::StaticOrder, true, true>(lds, g, S, E);
        }
        xcd_barrier(xbar);
    }
    final_norm(a.out, a.final_g, gw, ngw);
}

extern "C" void kernel_launch(void* const* d_in, const int* in_sizes, int n_in, void* d_out, int out_size, void* d_ws, size_t ws_size, hipStream_t stream) {
    static int grid = 0;
    if (grid == 0) {
        if (n_in != 19 || ws_size < WS_END) { fprintf(stderr, "kernel_launch: unexpected inputs (%d) or workspace (%zu < %zu)\n", n_in, ws_size, (size_t)WS_END); grid = -1; return; }
        int dev = 0, cus = 0, per_cu = 0;
        hipGetDevice(&dev); hipDeviceGetAttribute(&cus, hipDeviceAttributeMultiprocessorCount, dev);
        hipFuncSetAttribute((const void*)yoco_fwd, hipFuncAttributeMaxDynamicSharedMemorySize, LDS_BYTES);
        hipOccupancyMaxActiveBlocksPerMultiprocessor(&per_cu, (const void*)yoco_fwd, NTHREADS, LDS_BYTES);
        (void)hipGetLastError();
        if (per_cu < 1) per_cu = 1;
        grid = cus * per_cu;
    }
    if (grid < 0) return;
    Args a{};
    a.x = (const float*)d_in[0]; a.rel_bias = (const float*)d_in[1]; a.attn_g = (const float*)d_in[2]; a.ffn_g = (const float*)d_in[3]; a.w_qkv = (const float*)d_in[4]; a.w_o = (const float*)d_in[5];
    a.lq1 = (const float*)d_in[6]; a.lk1 = (const float*)d_in[7]; a.lq2 = (const float*)d_in[8]; a.lk2 = (const float*)d_in[9]; a.subln_g = (const float*)d_in[10]; a.kv_g = (const float*)d_in[11];
    a.w_kv = (const float*)d_in[12]; a.w_sq = (const float*)d_in[13]; a.w_so = (const float*)d_in[14]; a.w_gate = (const float*)d_in[15]; a.w_up = (const float*)d_in[16]; a.w_down = (const float*)d_in[17]; a.final_g = (const float*)d_in[18];
    a.out = (float*)d_out; a.ws = (unsigned char*)d_ws;
    hipMemsetAsync((char*)d_ws + 4096, 0, XCD_BAR_WORDS * 4, stream);
    void* args[] = {&a};
    hipError_t e = hipLaunchCooperativeKernel((const void*)yoco_fwd, dim3(grid), dim3(NTHREADS), args, LDS_BYTES, stream);
    if (e != hipSuccess) fprintf(stderr, "cooperative launch failed: %s (grid %d)\n", hipGetErrorString(e), grid);
}
```

```cpp
#include <hip/hip_runtime.h>
#include <hip/hip_cooperative_groups.h>
#include <cstdio>
#include <cstdint>
#include <cmath>
namespace cg = cooperative_groups;
namespace pg8 {
#define PG8_LAS __attribute__((address_space(3)))
typedef unsigned short bf16_t;
typedef short bf16x8 __attribute__((ext_vector_type(8)));
typedef float f32x4 __attribute__((ext_vector_type(4)));
typedef unsigned u32x4 __attribute__((ext_vector_type(4)));
constexpr int BM = 256, BK = 64, HALF = 128, HTB = HALF * BK * 2  , STAGE_BYTES = 8 * HTB, NXCD = 8, WGM = 8;

__host__ __device__ __forceinline__ int lds_byte(int r, int c) { const int st = (r >> 4) * 2 + (c >> 5), rr = r & 15, cc = c & 31, ob = rr * 64 + cc * 2; return st * 1024 + (ob ^ (((ob >> 9) & 1) << 5)); }
__host__ __device__ __forceinline__ void stage_rc(int b, int& R, int& C) { const int st = b / 1024, sb = b % 1024, swz = sb ^ (((sb >> 9) & 1) << 5); R = (st >> 1) * 16 + swz / 64; C = (st & 1) * 32 + (swz % 64) / 2; }
__host__ __device__ __forceinline__ int perm32(int rho) { const int n = rho >> 4, i = rho & 15; return 8 * (i >> 2) + 4 * n + (i & 3); }

struct Unit { int pm, pn; const unsigned short* A = nullptr; const unsigned short* Bt = nullptr; int id = 0; };
struct Gemm { const bf16_t* A; const bf16_t* Bt; int M, N, K; };

struct StaticOrder {
    int nM, nN, nwg, G, c;
    __host__ __device__ void init(int M, int N, int G_, int c_) { nM = M / BM; nN = N / BM; nwg = nM * nN; G = G_; c = c_; }
    __host__ __device__ bool next(int i, Unit& u) const {
        const long L = (long)i * G + c; if (L >= nwg) return false;
        int wgid = (int)L; { const int q = nwg / NXCD, r = nwg % NXCD, xcd = wgid % NXCD, off = wgid / NXCD; wgid = (xcd < r ? xcd * (q + 1) : r * (q + 1) + (xcd - r) * q) + off; }
        const int nig = WGM * nN, gid = wgid / nig, fm = gid * WGM, gsz = (nM - fm) < WGM ? (nM - fm) : WGM;
        u.pm = fm + ((wgid % nig) % gsz); u.pn = (wgid % nig) / gsz; return true;
    }
    __device__ __forceinline__ void a_ready(const Unit&) const {}
    __device__ __forceinline__ void done(const Unit&) const {}
};

__device__ __forceinline__ unsigned cvt_pk_bf16(float lo, float hi) { unsigned r; asm volatile("v_cvt_pk_bf16_f32 %0, %1, %2" : "=v"(r) : "v"(lo), "v"(hi)); return r; }
typedef float f32x2 __attribute__((ext_vector_type(2)));

typedef unsigned u32x2e __attribute__((ext_vector_type(2)));
__device__ __forceinline__ float row_rs(const float* part, int row) {
    const f32x4* p = (const f32x4*)(part + (size_t)row * 32); f32x4 s = p[0];
#pragma unroll
    for (int i = 1; i < 8; ++i) s += p[i];
    return __builtin_amdgcn_rsqf(((s[0] + s[1]) + (s[2] + s[3])) * (1.0f / 2048.0f) + 1e-5f);
}


template <bool COLS, class Sched> __device__ __forceinline__ void build_rtab(PG8_LAS float* tab, const float* part, const Sched& S) {
    int t_ = threadIdx.x; asm volatile("" : "+v"(t_));
    Unit u;
    for (int i = 0; i < 14 && S.next(i, u); ++i) { const int base = ((COLS || u.id == 1) ? u.pn : u.pm) * BM; if (t_ < 256) tab[i * 256 + t_] = row_rs(part, base + t_); }
    __syncthreads();
}
struct EpiBf16 {
    static constexpr bool PERM = true, AFTER_DRAIN = false;
    bf16_t* O; int ldc; int split_cols; size_t split_stride; float scale0; const PG8_LAS float* rtab;
    __device__ __forceinline__ void operator()(const f32x4 (&acc)[2][2][4][2], const Unit& u, int ui, int wr, int wc, int fr, int fq) const {
        const int row0 = u.pm * BM + wr * 64 + fr; int colt = u.pn * BM; bf16_t* base = O;
        float sc = 1.f; if (split_cols) { const int t = colt / split_cols; base += (size_t)t * split_stride; colt -= t * split_cols; if (t == 0) sc = scale0; }
        const int col0 = colt + wc * 32 + 8 * fq;
#pragma unroll
        for (int ai = 0; ai < 2; ++ai)
#pragma unroll
            for (int m = 0; m < 4; ++m) { bf16_t* rowp = base + (size_t)(row0 + ai * HALF + m * 16) * ldc + col0;
                const float rsc = sc * rtab[ui * 256 + wr * 64 + fr + ai * HALF + m * 16];
#pragma unroll
                for (int bj = 0; bj < 2; ++bj) { f32x4 v0 = acc[ai][bj][m][0] * rsc, v1 = acc[ai][bj][m][1] * rsc;
                    u32x4 w; w.x = cvt_pk_bf16(v0[0], v0[1]); w.y = cvt_pk_bf16(v0[2], v0[3]); w.z = cvt_pk_bf16(v1[0], v1[1]); w.w = cvt_pk_bf16(v1[2], v1[3]);
                    *(u32x4*)(rowp + bj * HALF) = w; } }
    }
};
struct EpiRes {
    static constexpr bool PERM = false, AFTER_DRAIN = false;
    const float* base; float* out; int ldc;
    __device__ __forceinline__ void operator()(const f32x4 (&acc)[2][2][4][2], const Unit& u, int ui, int wr, int wc, int fr, int fq) const {
        const int col0 = u.pn * BM + wc * 32 + 4 * fq;
#pragma unroll
        for (int ai = 0; ai < 2; ++ai)
#pragma unroll
            for (int m = 0; m < 4; ++m) { const size_t off = (size_t)(u.pm * BM + ai * HALF + wr * 64 + m * 16 + fr) * ldc + col0;
#pragma unroll
                for (int bj = 0; bj < 2; ++bj)
#pragma unroll
                    for (int n = 0; n < 2; ++n) { const f32x4 bs = *(const f32x4*)(base + off + bj * HALF + n * 16); *(f32x4*)(out + off + bj * HALF + n * 16) = bs + acc[ai][bj][m][n]; } }
    }
};
struct EpiSwiGLU {
    static constexpr bool PERM = true, AFTER_DRAIN = false;
    bf16_t* O; int ldc; const PG8_LAS float* rtab;
    __device__ __forceinline__ static float silu_mul(float g, float u) { return g * u * __builtin_amdgcn_rcpf(1.0f + __builtin_amdgcn_exp2f(-1.4426950408889634f * g)); }
    __device__ __forceinline__ void operator()(const f32x4 (&acc)[2][2][4][2], const Unit& u, int ui, int wr, int wc, int fr, int fq) const {
        const int row0 = u.pm * BM + wr * 64 + fr; const int col0 = u.pn * HALF + wc * 32 + 8 * fq;
#pragma unroll
        for (int ai = 0; ai < 2; ++ai)
#pragma unroll
            for (int m = 0; m < 4; ++m) { bf16_t* rowp = O + (size_t)(row0 + ai * HALF + m * 16) * ldc + col0;
                const float rsc = rtab[ui * 256 + wr * 64 + fr + ai * HALF + m * 16];
                const f32x4 g0 = acc[ai][0][m][0] * rsc, g1 = acc[ai][0][m][1] * rsc, u0 = acc[ai][1][m][0] * rsc, u1 = acc[ai][1][m][1] * rsc;
                u32x4 w; w.x = cvt_pk_bf16(silu_mul(g0[0], u0[0]), silu_mul(g0[1], u0[1])); w.y = cvt_pk_bf16(silu_mul(g0[2], u0[2]), silu_mul(g0[3], u0[3]));
                w.z = cvt_pk_bf16(silu_mul(g1[0], u1[0]), silu_mul(g1[1], u1[1])); w.w = cvt_pk_bf16(silu_mul(g1[2], u1[2]), silu_mul(g1[3], u1[3]));
                *(u32x4*)rowp = w; }
    }
};

struct EpiVT {
    static constexpr bool PERM = true, AFTER_DRAIN = false;
    bf16_t* O; const PG8_LAS float* rtab;
    __device__ __forceinline__ void operator()(const f32x4 (&acc)[2][2][4][2], const Unit& u, int ui, int wr, int wc, int fr, int fq) const {
        const int row0 = u.pm * BM + wr * 64 + fr; const int col0 = u.pn * BM + wc * 32 + 8 * fq;
        f32x4 cs[2][2];
#pragma unroll
        for (int bj = 0; bj < 2; ++bj)
#pragma unroll
            for (int n = 0; n < 2; ++n) cs[bj][n] = *(const PG8_LAS f32x4*)(rtab + ui * 256 + wc * 32 + 8 * fq + bj * HALF + 4 * n);
#pragma unroll
        for (int ai = 0; ai < 2; ++ai)
#pragma unroll
            for (int m = 0; m < 4; ++m) { const int ch = row0 + ai * HALF + m * 16;
#pragma unroll
                for (int bj = 0; bj < 2; ++bj) { const int col = col0 + bj * HALF; const f32x4 v0 = acc[ai][bj][m][0] * cs[bj][0], v1 = acc[ai][bj][m][1] * cs[bj][1];
                    u32x4 w; w.x = cvt_pk_bf16(v0[0], v0[1]); w.y = cvt_pk_bf16(v0[2], v0[3]); w.z = cvt_pk_bf16(v1[0], v1[1]); w.w = cvt_pk_bf16(v1[2], v1[3]);
                    *(u32x4*)(O + ((size_t)(col >> 6) * 2048 + ch) * 64 + (col & 63)) = w; } }
    }
};

struct EpiResN {
    static constexpr bool PERM = false, AFTER_DRAIN = false;
    const float* base; float* out; int ldc; bf16_t* XH; float* ssq;
    __device__ __forceinline__ void operator()(const f32x4 (&acc)[2][2][4][2], const Unit& u, int ui, int wr, int wc, int fr, int fq) const {
        const int col0 = u.pn * BM + wc * 32 + 4 * fq; const int rowb = u.pm * BM + wr * 64 + fr;
        f32x4 nxt[2][2];
#pragma unroll
        for (int bj = 0; bj < 2; ++bj)
#pragma unroll
            for (int n = 0; n < 2; ++n) nxt[bj][n] = *(const f32x4*)(base + (size_t)rowb * ldc + col0 + bj * HALF + n * 16);
#pragma unroll
        for (int g = 0; g < 8; ++g) { const int ai = g >> 2, m = g & 3; const int row = rowb + ai * HALF + m * 16; const size_t off = (size_t)row * ldc + col0;
            f32x4 cur[2][2];
#pragma unroll
            for (int bj = 0; bj < 2; ++bj)
#pragma unroll
                for (int n = 0; n < 2; ++n) cur[bj][n] = nxt[bj][n];
            if (g + 1 < 8) { const int row2 = rowb + ((g + 1) >> 2) * HALF + ((g + 1) & 3) * 16;
#pragma unroll
                for (int bj = 0; bj < 2; ++bj)
#pragma unroll
                    for (int n = 0; n < 2; ++n) nxt[bj][n] = *(const f32x4*)(base + (size_t)row2 * ldc + col0 + bj * HALF + n * 16); }
            float ss = 0.f;
#pragma unroll
            for (int bj = 0; bj < 2; ++bj)
#pragma unroll
                for (int n = 0; n < 2; ++n) { const f32x4 v = cur[bj][n] + acc[ai][bj][m][n]; *(f32x4*)(out + off + bj * HALF + n * 16) = v;
                    if (XH) { u32x2e w; w.x = cvt_pk_bf16(v[0], v[1]); w.y = cvt_pk_bf16(v[2], v[3]); *(u32x2e*)(XH + off + bj * HALF + n * 16) = w; }
                    ss += (v[0] * v[0] + v[1] * v[1]) + (v[2] * v[2] + v[3] * v[3]); }
            if (XH) {
            ss += __int_as_float(__builtin_amdgcn_ds_swizzle(__float_as_int(ss), (16 << 10) | 0x1f));
            { auto rr = __builtin_amdgcn_permlane32_swap(__float_as_uint(ss), __float_as_uint(ss), false, false); ss = __uint_as_float(rr[0]) + __uint_as_float(rr[1]); }
            if (fq == 0) ssq[(size_t)row * 32 + u.pn * 4 + wc] = ss; } }
    }
};

struct MultiOrder {
    StaticOrder s0, s1, s2; const bf16_t *A0, *B0, *A1, *B1, *A2, *B2; int n0, n1, n2;
    __device__ __forceinline__ static int count(const StaticOrder& s) { return s.nwg > s.c ? (s.nwg - s.c + s.G - 1) / s.G : 0; }
    __device__ __forceinline__ bool next(int i, Unit& u) const {
        if (i < n0) { s0.next(i, u); u.A = A0; u.Bt = B0; u.id = 0; return true; } i -= n0;
        if (i < n1) { s1.next(i, u); u.A = A1; u.Bt = B1; u.id = 1; return true; } i -= n1;
        if (i < n2) { s2.next(i, u); u.A = A2; u.Bt = B2; u.id = 2; return true; }
        return false;
    }
    __device__ __forceinline__ void a_ready(const Unit&) const {}
    __device__ __forceinline__ void done(const Unit&) const {}
};
struct EpiMulti {
    static constexpr bool PERM = true, AFTER_DRAIN = false;
    EpiBf16 e0; EpiVT e1; EpiBf16 e2;
    __device__ __forceinline__ void operator()(const f32x4 (&acc)[2][2][4][2], const Unit& u, int ui, int wr, int wc, int fr, int fq) const {
        if (u.id == 0) e0(acc, u, ui, wr, wc, fr, fq); else if (u.id == 1) e1(acc, u, ui, wr, wc, fr, fq); else e2(acc, u, ui, wr, wc, fr, fq);
    }
};

template <class Epi, class Sched, bool ALIGN_EPI = false, bool SP2 = false>
__device__ __forceinline__ void gemm_phase(PG8_LAS unsigned char* lds, const Gemm g, const Sched& S, const Epi& E) {
    int tid_ = threadIdx.x; asm volatile("" : "+v"(tid_));
    const int tid = tid_, wid = __builtin_amdgcn_readfirstlane(tid >> 6), lane = tid & 63, wr = wid >> 2, wc = wid & 3, fr = lane & 15, fq = lane >> 4;
    const int K = g.K, nt = K / BK;
    unsigned voffA[2], voffB[2];
#pragma unroll
    for (int i = 0; i < 2; ++i) { int R, C; stage_rc(tid * 16 + i * 8192, R, C); const int Rb = Epi::PERM ? ((R & ~31) + perm32(R & 31)) : R;
        voffA[i] = (unsigned)(R * K + C) * 2u; voffB[i] = (unsigned)(Rb * K + C) * 2u; }
    const size_t kstep = (size_t)(BK * 2);
    const size_t hstep = (size_t)HALF * K * 2;
    const size_t tstep = 2 * hstep;
    const unsigned ldsw = (unsigned)wid * 1024u;
    const int aoff = lds_byte(wr * 64 + fr, fq * 8), boff = lds_byte(wc * 32 + fr, fq * 8);
#define PG8_SA(b, h) (((b) * 2 + (h)) * HTB)
#define PG8_SB(b, h) ((4 + (b) * 2 + (h)) * HTB)
#define PG8_STAGE(bufoff, gbase, voff) do { _Pragma("unroll") for (int _i = 0; _i < 2; ++_i) \
        __builtin_amdgcn_global_load_lds((const unsigned*)((const char*)(gbase) + (voff)[_i]), (PG8_LAS unsigned*)(lds + (bufoff) + ldsw + _i * 8192), 16, 0, 0); } while (0)
#define PG8_LDA(dst, b, h) do { _Pragma("unroll") for (int m = 0; m < 4; ++m) _Pragma("unroll") for (int k = 0; k < 2; ++k) dst[m][k] = *(const PG8_LAS bf16x8*)(lds + PG8_SA(b, h) + aoff + m * 2048 + k * 1024); } while (0)
#define PG8_LDB(dst, b, h) do { _Pragma("unroll") for (int n = 0; n < 2; ++n) _Pragma("unroll") for (int k = 0; k < 2; ++k) dst[n][k] = *(const PG8_LAS bf16x8*)(lds + PG8_SB(b, h) + boff + n * 2048 + k * 1024); } while (0)
#define PG8_MMA(ai, bj, At, Bt) do { __builtin_amdgcn_s_setprio(1); _Pragma("unroll") for (int m = 0; m < 4; ++m) _Pragma("unroll") for (int n = 0; n < 2; ++n) _Pragma("unroll") for (int k = 0; k < 2; ++k) \
        acc[ai][bj][m][n] = __builtin_amdgcn_mfma_f32_16x16x32_bf16(Bt[n][k], At[m][k], acc[ai][bj][m][n], 0, 0, 0); __builtin_amdgcn_s_setprio(0); } while (0)
#define PG8_WAIT_V(n) asm volatile("s_waitcnt vmcnt(" #n ")" ::: "memory")
#define PG8_WAIT_L(n) asm volatile("s_waitcnt lgkmcnt(" #n ")" ::: "memory")
#define PG8_BAR __builtin_amdgcn_s_barrier()
#define PG8_SCHED __builtin_amdgcn_sched_barrier(0)
    Unit cur, nxt; int ui = 0;
    if (!S.next(0, cur)) return;
    f32x4 acc[2][2][4][2];
#pragma unroll
    for (int a = 0; a < 2; ++a)
#pragma unroll
        for (int b = 0; b < 2; ++b)
#pragma unroll
            for (int m = 0; m < 4; ++m)
#pragma unroll
                for (int n = 0; n < 2; ++n) acc[a][b][m][n] = (f32x4){0.f, 0.f, 0.f, 0.f};
    bf16x8 At[4][2], B0[2][2], B1[2][2];
    const char* cA = (const char*)(cur.A ? cur.A : g.A) + (size_t)cur.pm * tstep; const char* cB = (const char*)(cur.Bt ? cur.Bt : g.Bt) + (size_t)cur.pn * tstep;
    S.a_ready(cur);
    if constexpr (SP2) {
        PG8_STAGE(PG8_SB(0, 0), cB, voffB); PG8_STAGE(PG8_SB(0, 1), cB + hstep, voffB); PG8_STAGE(PG8_SA(0, 0), cA, voffA); PG8_STAGE(PG8_SA(0, 1), cA + hstep, voffA);
        if (wr == 1) PG8_BAR;
        PG8_WAIT_V(2); PG8_BAR;
        PG8_STAGE(PG8_SB(1, 0), cB + kstep, voffB); PG8_STAGE(PG8_SA(1, 0), cA + kstep, voffA); PG8_STAGE(PG8_SB(1, 1), cB + hstep + kstep, voffB);
        PG8_WAIT_V(6); PG8_BAR;
    } else {
        PG8_STAGE(PG8_SB(0, 0), cB, voffB); PG8_STAGE(PG8_SA(0, 0), cA, voffA); PG8_STAGE(PG8_SB(0, 1), cB + hstep, voffB); PG8_STAGE(PG8_SA(0, 1), cA + hstep, voffA);
        if (wr == 1) PG8_BAR;
        PG8_WAIT_V(4); PG8_BAR;
        PG8_STAGE(PG8_SB(1, 0), cB + kstep, voffB); PG8_STAGE(PG8_SA(1, 0), cA + kstep, voffA); PG8_STAGE(PG8_SB(1, 1), cB + hstep + kstep, voffB);
        PG8_WAIT_V(6); PG8_BAR;
    }
    for (;;) {
        const bool has_next = S.next(ui + 1, nxt);
        const char* nA = has_next ? (const char*)(nxt.A ? nxt.A : g.A) + (size_t)nxt.pm * tstep : cA; const char* nB = has_next ? (const char*)(nxt.Bt ? nxt.Bt : g.Bt) + (size_t)nxt.pn * tstep : cB;
        for (int t = 0; t < nt; t += 2) {
            const bool last = (t == nt - 2);
            const char* a1 = cA + (size_t)(t + 1) * kstep;
            const char* a2 = last ? nA : cA + (size_t)(t + 2) * kstep; const char* b2 = last ? nB : cB + (size_t)(t + 2) * kstep;
            const char* a3 = a2 + kstep; const char* b3 = b2 + kstep;
            if (last && has_next) S.a_ready(nxt);
            if constexpr (SP2) {
            PG8_LDB(B0, 0, 0); PG8_LDB(B1, 0, 1); PG8_SCHED; PG8_LDA(At, 0, 0); PG8_STAGE(PG8_SA(1, 1), a1 + hstep, voffA);
            PG8_WAIT_V(8); PG8_WAIT_L(0); PG8_BAR; PG8_MMA(0, 0, At, B0); PG8_MMA(0, 1, At, B1); PG8_BAR; PG8_SCHED;
            PG8_LDA(At, 0, 1); PG8_STAGE(PG8_SB(0, 0), b2, voffB); PG8_STAGE(PG8_SB(0, 1), b2 + hstep, voffB); PG8_STAGE(PG8_SA(0, 0), a2, voffA);
            PG8_WAIT_V(8); PG8_WAIT_L(0); PG8_BAR; PG8_MMA(1, 0, At, B0); PG8_MMA(1, 1, At, B1); PG8_BAR; PG8_SCHED;
            PG8_LDB(B0, 1, 0); PG8_LDB(B1, 1, 1); PG8_SCHED; PG8_LDA(At, 1, 0); PG8_STAGE(PG8_SA(0, 1), a2 + hstep, voffA);
            PG8_WAIT_V(8); PG8_WAIT_L(0); PG8_BAR; PG8_MMA(0, 0, At, B0); PG8_MMA(0, 1, At, B1); PG8_BAR; PG8_SCHED;
            PG8_LDA(At, 1, 1); PG8_STAGE(PG8_SB(1, 0), b3, voffB); PG8_STAGE(PG8_SB(1, 1), b3 + hstep, voffB); PG8_STAGE(PG8_SA(1, 0), a3, voffA);
            PG8_WAIT_V(8); PG8_WAIT_L(0); PG8_BAR; PG8_MMA(1, 0, At, B0); PG8_MMA(1, 1, At, B1); PG8_BAR; PG8_SCHED;
            } else {
            PG8_LDB(B0, 0, 0); PG8_SCHED; PG8_LDA(At, 0, 0); PG8_STAGE(PG8_SA(1, 1), a1 + hstep, voffA);
            PG8_WAIT_L(8); PG8_BAR; PG8_WAIT_L(0); PG8_MMA(0, 0, At, B0); PG8_BAR; PG8_SCHED;
            PG8_LDB(B1, 0, 1); PG8_STAGE(PG8_SB(0, 0), b2, voffB);
            PG8_BAR; PG8_WAIT_L(0); PG8_MMA(0, 1, At, B1); PG8_BAR;
            PG8_LDA(At, 0, 1); PG8_STAGE(PG8_SA(0, 0), a2, voffA);
            PG8_BAR; PG8_WAIT_L(0); PG8_MMA(1, 0, At, B0); PG8_BAR; PG8_SCHED;
            PG8_STAGE(PG8_SB(0, 1), b2 + hstep, voffB);
            PG8_WAIT_V(6); PG8_BAR; PG8_MMA(1, 1, At, B1); PG8_BAR;
            PG8_LDB(B0, 1, 0); PG8_SCHED; PG8_LDA(At, 1, 0); PG8_STAGE(PG8_SA(0, 1), a2 + hstep, voffA);
            PG8_WAIT_L(8); PG8_BAR; PG8_WAIT_L(0); PG8_MMA(0, 0, At, B0); PG8_BAR; PG8_SCHED;
            PG8_LDB(B1, 1, 1); PG8_STAGE(PG8_SB(1, 0), b3, voffB);
            PG8_BAR; PG8_WAIT_L(0); PG8_MMA(0, 1, At, B1); PG8_BAR;
            PG8_LDA(At, 1, 1); PG8_STAGE(PG8_SA(1, 0), a3, voffA);
            PG8_BAR; PG8_WAIT_L(0); PG8_MMA(1, 0, At, B0); PG8_BAR; PG8_SCHED;
            PG8_STAGE(PG8_SB(1, 1), b3 + hstep, voffB);
            PG8_WAIT_V(6); PG8_BAR; PG8_MMA(1, 1, At, B1); PG8_BAR;
            }
        }
        if constexpr (ALIGN_EPI) { if (wr == 0) PG8_BAR; }
        if constexpr (!Epi::AFTER_DRAIN) { E(acc, cur, ui, wr, wc, fr, fq); S.done(cur); }
        if (!has_next) break;
#pragma unroll
        for (int a = 0; a < 2; ++a)
#pragma unroll
            for (int b = 0; b < 2; ++b)
#pragma unroll
                for (int m = 0; m < 4; ++m)
#pragma unroll
                    for (int n = 0; n < 2; ++n) acc[a][b][m][n] = (f32x4){0.f, 0.f, 0.f, 0.f};
        cur = nxt; cA = nA; cB = nB; ++ui;
        if constexpr (ALIGN_EPI) { if (wr == 1) PG8_BAR; }
    }
    PG8_WAIT_V(0);
    if constexpr (!ALIGN_EPI) { if (wr == 0) PG8_BAR; }
    PG8_BAR;
    if constexpr (Epi::AFTER_DRAIN) { E.fused(acc, cur, wr, wc, fr, fq, lds, wid, lane); S.done(cur); }
#undef PG8_SA
#undef PG8_SB
#undef PG8_STAGE
#undef PG8_LDA
#undef PG8_LDB
#undef PG8_MMA
#undef PG8_WAIT_V
#undef PG8_WAIT_L
#undef PG8_BAR
#undef PG8_SCHED
}
}

#define LAS __attribute__((address_space(3)))
typedef unsigned short bf16;
typedef short bf16x8 __attribute__((ext_vector_type(8)));
typedef float f32x4 __attribute__((ext_vector_type(4)));
typedef float f32x16 __attribute__((ext_vector_type(16)));
typedef unsigned u32x4 __attribute__((ext_vector_type(4)));
typedef unsigned u32x2 __attribute__((ext_vector_type(2)));

constexpr int NWAVES = 8, NTHREADS = 512;
constexpr int BATCH = 2, SEQ = 8192, DM = 2048, FF = 5632, MTOK = BATCH * SEQ;
constexpr float RMS_EPS = 1e-5f;
constexpr float LOG2E = 1.4426950408889634f, LN2 = 0.6931471805599453f;
constexpr int LDS_BYTES = 147456;

constexpr size_t MiB = 1u << 20;
constexpr size_t WS_WQKV = 2 * MiB;
constexpr size_t WS_WO   = WS_WQKV + 48 * MiB;
constexpr size_t WS_WKV  = WS_WO + 16 * MiB;
constexpr size_t WS_WSQ  = WS_WKV + 16 * MiB;
constexpr size_t WS_WSO  = WS_WSQ + 16 * MiB;
constexpr size_t WS_WGU  = WS_WSO + 16 * MiB;
constexpr size_t WS_WD   = WS_WGU + 176 * MiB;
constexpr size_t WS_XN   = WS_WD + 88 * MiB;
constexpr size_t WS_BIG  = WS_XN + 64 * MiB;
constexpr size_t WS_KS   = WS_BIG + 192 * MiB;
constexpr size_t WS_VTS  = WS_KS + 64 * MiB;
constexpr size_t WS_XH   = WS_VTS + 64 * MiB;
constexpr size_t WS_SSQ  = WS_XH + 64 * MiB;
constexpr size_t WS_END  = WS_SSQ + 18 * MiB;

__device__ __forceinline__ int fresh_tid() { int t = threadIdx.x; asm volatile("" : "+v"(t)); return t; }
#define SWZ_XOR(v, k) __int_as_float(__builtin_amdgcn_ds_swizzle(__float_as_int(v), ((k) << 10) | 0x1f))
__device__ __forceinline__ float wave_sum(float v) {
    v += SWZ_XOR(v, 1); v += SWZ_XOR(v, 2); v += SWZ_XOR(v, 4); v += SWZ_XOR(v, 8); v += SWZ_XOR(v, 16);
    auto rr = __builtin_amdgcn_permlane32_swap(__float_as_uint(v), __float_as_uint(v), false, false);
    return __uint_as_float(rr[0]) + __uint_as_float(rr[1]);
}
__device__ __forceinline__ unsigned cvtpk(float lo, float hi) { unsigned r; asm volatile("v_cvt_pk_bf16_f32 %0, %1, %2" : "=v"(r) : "v"(lo), "v"(hi)); return r; }
__device__ __forceinline__ float swap32(float v) {
    auto rr = __builtin_amdgcn_permlane32_swap(__float_as_uint(v), __float_as_uint(v), false, false);
    return (threadIdx.x & 32) ? __uint_as_float(rr[0]) : __uint_as_float(rr[1]);
}

__device__ __forceinline__ void transpose_item(const float* W, int K, int N, bf16* WT, int mode, LAS float* scr, int item, int lane, const float* gain = nullptr) {
    const int nblk = N / 32, kb = item / nblk, nb = item % nblk, k0 = 64 * kb, n0 = 32 * nb;
    int drow = n0;
    if (mode == 1) drow = 256 * (n0 >> 7) + (n0 & 127);
    if (mode == 2) drow = 256 * (n0 >> 7) + 128 + (n0 & 127);
    {
        f32x4 wv[8];
#pragma unroll
        for (int i = 0; i < 8; ++i) { const int f = i * 64 + lane; wv[i] = __builtin_nontemporal_load((const f32x4*)(W + (size_t)(k0 + (f >> 3)) * N + n0 + (f & 7) * 4)); }
#pragma unroll
        for (int i = 0; i < 8; ++i) { const int f = i * 64 + lane; LAS float* d = scr + (f >> 3) * 33 + (f & 7) * 4; d[0] = wv[i].x; d[1] = wv[i].y; d[2] = wv[i].z; d[3] = wv[i].w; }
    }
    asm volatile("s_waitcnt lgkmcnt(0)" ::: "memory");
    const int c = lane & 7;
    f32x4 ga = (f32x4){1.f, 1.f, 1.f, 1.f}, gb = ga;
    if (gain) { ga = *(const f32x4*)(gain + k0 + 8 * c); gb = *(const f32x4*)(gain + k0 + 8 * c + 4); }
#pragma unroll
    for (int j = 0; j < 4; ++j) { const int n = (lane >> 3) + 8 * j; const LAS float* s = scr + (8 * c) * 33 + n;
        u32x4 o; o.x = cvtpk(s[0 * 33] * ga.x, s[1 * 33] * ga.y); o.y = cvtpk(s[2 * 33] * ga.z, s[3 * 33] * ga.w); o.z = cvtpk(s[4 * 33] * gb.x, s[5 * 33] * gb.y); o.w = cvtpk(s[6 * 33] * gb.z, s[7 * 33] * gb.w);
        *(u32x4*)(WT + (size_t)(drow + n) * K + k0 + 8 * c) = o; }
    asm volatile("s_waitcnt lgkmcnt(0)" ::: "memory");
}

__device__ __forceinline__ void norm_rows(const float* src, const float* g1, bf16* d1, const float* g2, bf16* d2, int gw, int ngw) {
    const int lane = fresh_tid() & 63;
    for (int m = gw; m < MTOK; m += ngw) {
        const f32x4* xr = (const f32x4*)(src + (size_t)m * DM) + lane;
        f32x4 v[8]; float s = 0.f;
#pragma unroll
        for (int j = 0; j < 8; ++j) { v[j] = xr[64 * j]; s += (v[j].x * v[j].x + v[j].y * v[j].y) + (v[j].z * v[j].z + v[j].w * v[j].w); }
        const float r = 1.0f / sqrtf(wave_sum(s) * (1.0f / DM) + RMS_EPS);
        u32x2* o1 = (u32x2*)(d1 + (size_t)m * DM) + lane;
#pragma unroll
        for (int j = 0; j < 8; ++j) { const f32x4 g = ((const f32x4*)g1)[lane + 64 * j]; u32x2 w; w.x = cvtpk(v[j].x * r * g.x, v[j].y * r * g.y); w.y = cvtpk(v[j].z * r * g.z, v[j].w * r * g.w); o1[64 * j] = w; }
        if (d2) { u32x2* o2 = (u32x2*)(d2 + (size_t)m * DM) + lane;
#pragma unroll
            for (int j = 0; j < 8; ++j) { const f32x4 g = ((const f32x4*)g2)[lane + 64 * j]; u32x2 w; w.x = cvtpk(v[j].x * r * g.x, v[j].y * r * g.y); w.y = cvtpk(v[j].z * r * g.z, v[j].w * r * g.w); o2[64 * j] = w; } }
    }
}
__device__ __forceinline__ void cast_rows(const float* src, bf16* d1, float* ssq, int gw, int ngw) {
    const int lane = fresh_tid() & 63;
    for (int m = gw; m < MTOK; m += ngw) {
        const f32x4* xr = (const f32x4*)(src + (size_t)m * DM) + lane;
        f32x4 v[8]; float s = 0.f;
#pragma unroll
        for (int j = 0; j < 8; ++j) { v[j] = xr[64 * j]; s += (v[j].x * v[j].x + v[j].y * v[j].y) + (v[j].z * v[j].z + v[j].w * v[j].w); }
        s = wave_sum(s);
        u32x2* o1 = (u32x2*)(d1 + (size_t)m * DM) + lane;
#pragma unroll
        for (int j = 0; j < 8; ++j) { u32x2 w; w.x = cvtpk(v[j].x, v[j].y); w.y = cvtpk(v[j].z, v[j].w); o1[64 * j] = w; }
        if (lane < 32) ssq[(size_t)m * 32 + lane] = lane == 0 ? s : 0.f;
    }
}
__device__ __forceinline__ void final_norm(float* io, const float* g1, int gw, int ngw) {
    const int lane = fresh_tid() & 63;
    for (int m = gw; m < MTOK; m += ngw) {
        f32x4* xr = (f32x4*)(io + (size_t)m * DM) + lane;
        f32x4 v[8]; float s = 0.f;
#pragma unroll
        for (int j = 0; j < 8; ++j) { v[j] = xr[64 * j]; s += (v[j].x * v[j].x + v[j].y * v[j].y) + (v[j].z * v[j].z + v[j].w * v[j].w); }
        const float r = 1.0f / sqrtf(wave_sum(s) * (1.0f / DM) + RMS_EPS);
#pragma unroll
        for (int j = 0; j < 8; ++j) { const f32x4 g = ((const f32x4*)g1)[lane + 64 * j]; xr[64 * j] = v[j] * r * g; }
    }
}

__device__ __forceinline__ int kperm(int r) { return (r & 0x13) | ((r & 4) << 1) | ((r & 8) >> 1); }
__device__ __forceinline__ int crow(int r, int hi) { return (r & 3) + 8 * (r >> 2) + 4 * hi; }

namespace dattn {
constexpr int NS = 4, STAGE = 32768, KSUB = 8192, VOFF = 16384;
constexpr int LUT_OFF = NS * STAGE;
constexpr int NUNITS = BATCH * 16 * 64;
#define DA_WAITV(n) asm volatile("s_waitcnt vmcnt(" #n ")" ::: "memory")

__device__ __forceinline__ void unit(int b, int h, int qb, const bf16* __restrict__ Q, const bf16* __restrict__ K, const bf16* __restrict__ VT, bf16* __restrict__ O,
                                     LAS unsigned char* lds, float lam, const float* __restrict__ subg, float outscale) {
    int tid_ = threadIdx.x; asm volatile("" : "+v"(tid_));
    const int tid = tid_, lane = tid & 63, r32 = lane & 31, hi = lane >> 5;
    const int wid = __builtin_amdgcn_readfirstlane(tid >> 6), c = wid & 1, rg = wid >> 1;
    const int Q0 = qb * 128, qw = Q0 + 32 * rg, q = qw + r32;
    const int NT = Q0 / 64 + 2;
    const size_t tok0 = (size_t)b * SEQ;
    const LAS float* lut = (const LAS float*)(lds + LUT_OFF);
    bf16x8 qf[4];
    { const bf16* qp = Q + (tok0 + q) * DM + (2 * h + c) * 64 + 8 * hi;
#pragma unroll
      for (int ks = 0; ks < 4; ++ks) qf[ks] = *(const bf16x8*)(qp + 16 * ks); }
    const int drow = 8 * wid + (lane >> 3), dch = (lane & 7) ^ ((drow >> 1) & 7);
    const int kgo = drow * DM + dch * 8, vgo = drow * 64 + dch * 8;
    const bf16* kgb = K + tok0 * DM + (2 * h) * 64;
    const bf16* vgb = VT + ((size_t)(b * 128) * 2048 + h * 128) * 64;
    const int dpiece = wid * 1024;
#define DA_DMA(t, st) do { const bf16* kb_ = kgb + (size_t)(t) * 64 * DM + kgo; const bf16* vb_ = vgb + (size_t)(t) * 2048 * 64 + vgo; LAS unsigned char* l_ = lds + (st) * STAGE + dpiece; \
        __builtin_amdgcn_global_load_lds((const unsigned*)kb_, (LAS unsigned*)l_, 16, 0, 0); \
        __builtin_amdgcn_global_load_lds((const unsigned*)(kb_ + 64), (LAS unsigned*)(l_ + KSUB), 16, 0, 0); \
        __builtin_amdgcn_global_load_lds((const unsigned*)vb_, (LAS unsigned*)(l_ + VOFF), 16, 0, 0); \
        __builtin_amdgcn_global_load_lds((const unsigned*)(vb_ + 64 * 64), (LAS unsigned*)(l_ + VOFF + 8192), 16, 0, 0); } while (0)
    DA_DMA(0, 0); DA_DMA(1, 1);
#pragma unroll
    for (int ks = 0; ks < 4; ++ks) asm volatile("" : "+v"(qf[ks]));
    f32x16 o[4];
#pragma unroll
    for (int i = 0; i < 4; ++i) o[i] = f32x16{};
    float m = 0.f, l = 0.f; f32x16 negm = f32x16{}; asm volatile("" : "+v"(negm));
    const int kr_ = kperm(r32);
    const int kbase_ = c * KSUB + kr_ * 128, kx16 = (hi ^ ((kr_ >> 1) & 7)) << 4, vbase_ = VOFF + r32 * 128, vx16 = (hi ^ ((r32 >> 1) & 7)) << 4;
#define koffk_(i) (kbase_ + ((32 * (i)) ^ kx16))
#define voffj_(i) (vbase_ + ((32 * (i)) ^ vx16))
    f32x16 pA0 = f32x16{}, pA1 = f32x16{}, pB0, pB1;
#define SBAR() __builtin_amdgcn_sched_barrier(0)
#define LDF(p) (*(const LAS bf16x8*)(p))
#define GA(MF, X, B, W, L, H) do { MF; sacc += X[B]; sacc += X[B + 1]; sacc += X[B + 2]; sacc += X[B + 3]; asm volatile("" : "+v"(sacc)); W.L = cvtpk(X[B], X[B + 1]); W.H = cvtpk(X[B + 2], X[B + 3]); asm volatile("" : "+v"(W)); SBAR(); } while (0)
#define GB(MF, X, B) do { MF; X[B] = __builtin_amdgcn_exp2f(X[B]); X[B + 1] = __builtin_amdgcn_exp2f(X[B + 1]); asm volatile("" : "+v"(X)); SBAR(); } while (0)
#define MF32(a, b, c) __builtin_amdgcn_mfma_f32_32x32x16_bf16(a, b, c, 0, 0, 0)
#define DA_STEP(tt, C0, C1, P0, P1) do { const int t_ = (tt), k0_ = 64 * t_; \
        DA_WAITV(4); __builtin_amdgcn_s_barrier(); \
        { int tn = t_ + 2; tn = tn < NT ? tn : NT - 1; DA_DMA(tn, (t_ + 2) & 3); } \
        const LAS unsigned char* sk_ = lds + (t_ & 3) * STAGE; const LAS unsigned char* sv_ = lds + ((t_ ? t_ - 1 : 0) & 3) * STAGE; \
        bf16x8 kf[8], va[4], vb[4]; u32x4 pw0, pw1, pw2, pw3; \
        _Pragma("unroll") for (int i = 0; i < 8; ++i) kf[i] = LDF(sk_ + koffk_(i & 3) + (i >> 2) * 4096); \
        _Pragma("unroll") for (int db = 0; db < 4; ++db) va[db] = LDF(sv_ + voffj_(0) + db * 4096); \
        SBAR(); float sacc = 0.f; \
        GA(C0 = MF32(kf[0], qf[0], negm), P0, 0, pw0, x, y); \
        GA(C1 = MF32(kf[4], qf[0], negm), P0, 4, pw0, z, w); \
        GA(C0 = MF32(kf[1], qf[1], C0), P0, 8, pw1, x, y); \
        GA(C1 = MF32(kf[5], qf[1], C1), P0, 12, pw1, z, w); \
        GA(C0 = MF32(kf[2], qf[2], C0), P1, 0, pw2, x, y); \
        GA(C1 = MF32(kf[6], qf[2], C1), P1, 4, pw2, z, w); \
        GA(C0 = MF32(kf[3], qf[3], C0), P1, 8, pw3, x, y); \
        GA(C1 = MF32(kf[7], qf[3], C1), P1, 12, pw3, z, w); \
        _Pragma("unroll") for (int db = 0; db < 4; ++db) vb[db] = LDF(sv_ + voffj_(1) + db * 4096); \
        l += sacc; \
        if (qw - (k0_ + 63) < 128) { \
            _Pragma("unroll") for (int r = 0; r < 16; ++r) { const int rel = q - (k0_ + 16 * (r >> 3) + 8 * hi + (r & 7)); \
                C0[r] += lut[min(max(rel + 1, 0), 128)]; C1[r] += lut[min(max(rel - 31, 0), 128)]; } } \
        float mx = C0[0]; \
        _Pragma("unroll") for (int r = 1; r < 16; ++r) mx = fmaxf(mx, C0[r]); \
        _Pragma("unroll") for (int r = 0; r < 16; ++r) mx = fmaxf(mx, C1[r]); \
        mx = fmaxf(mx, swap32(mx)); \
        bool resc = false; float alpha = 1.f; \
        if (t_ == 0 || __any(mx > 8.0f)) {        \
            const float dl = (t_ == 0) ? mx : fmaxf(mx, 0.f); m += dl; alpha = (t_ == 0) ? 1.f : __builtin_amdgcn_exp2f(-dl); resc = (t_ != 0); \
            _Pragma("unroll") for (int r = 0; r < 16; ++r) { C0[r] -= dl; C1[r] -= dl; } \
            _Pragma("unroll") for (int r = 0; r < 16; ++r) negm[r] = -m; asm volatile("" : "+v"(negm)); } \
        SBAR(); \
        const bf16x8 f0 = __builtin_bit_cast(bf16x8, pw0), f1 = __builtin_bit_cast(bf16x8, pw1), f2 = __builtin_bit_cast(bf16x8, pw2), f3 = __builtin_bit_cast(bf16x8, pw3); \
        bf16x8 vc[4], vd[4]; \
        GB(o[0] = MF32(va[0], f0, o[0]), C0, 0); \
        _Pragma("unroll") for (int db = 0; db < 4; ++db) vc[db] = LDF(sv_ + voffj_(2) + db * 4096); \
        GB(o[1] = MF32(va[1], f0, o[1]), C0, 2); GB(o[2] = MF32(va[2], f0, o[2]), C0, 4); GB(o[3] = MF32(va[3], f0, o[3]), C0, 6); \
        GB(o[0] = MF32(vb[0], f1, o[0]), C0, 8); \
        _Pragma("unroll") for (int db = 0; db < 4; ++db) vd[db] = LDF(sv_ + voffj_(3) + db * 4096); \
        GB(o[1] = MF32(vb[1], f1, o[1]), C0, 10); GB(o[2] = MF32(vb[2], f1, o[2]), C0, 12); GB(o[3] = MF32(vb[3], f1, o[3]), C0, 14); \
        GB(o[0] = MF32(vc[0], f2, o[0]), C1, 0); GB(o[1] = MF32(vc[1], f2, o[1]), C1, 2); GB(o[2] = MF32(vc[2], f2, o[2]), C1, 4); GB(o[3] = MF32(vc[3], f2, o[3]), C1, 6); \
        GB(o[0] = MF32(vd[0], f3, o[0]), C1, 8); GB(o[1] = MF32(vd[1], f3, o[1]), C1, 10); GB(o[2] = MF32(vd[2], f3, o[2]), C1, 12); GB(o[3] = MF32(vd[3], f3, o[3]), C1, 14); \
        if (resc) { _Pragma("unroll") for (int i = 0; i < 4; ++i) o[i] *= alpha; l *= alpha; } \
    } while (0)
    for (int t = 0; t < NT; t += 2) {
        DA_STEP(t, pB0, pB1, pA0, pA1);
        DA_STEP(t + 1, pA0, pA1, pB0, pB1);
    }
    {
        const LAS unsigned char* sv_ = lds + ((NT - 1) & 3) * STAGE;
        float sacc = 0.f; u32x4 pw[4];
#pragma unroll
        for (int r = 0; r < 16; ++r) sacc += pA0[r];
#pragma unroll
        for (int r = 0; r < 16; ++r) sacc += pA1[r];
        l += sacc;
#pragma unroll
        for (int j = 0; j < 2; ++j) { pw[j] = (u32x4){cvtpk(pA0[8 * j], pA0[8 * j + 1]), cvtpk(pA0[8 * j + 2], pA0[8 * j + 3]), cvtpk(pA0[8 * j + 4], pA0[8 * j + 5]), cvtpk(pA0[8 * j + 6], pA0[8 * j + 7])};
            pw[2 + j] = (u32x4){cvtpk(pA1[8 * j], pA1[8 * j + 1]), cvtpk(pA1[8 * j + 2], pA1[8 * j + 3]), cvtpk(pA1[8 * j + 4], pA1[8 * j + 5]), cvtpk(pA1[8 * j + 6], pA1[8 * j + 7])}; }
#pragma unroll
        for (int j = 0; j < 4; ++j) { const bf16x8 f = __builtin_bit_cast(bf16x8, pw[j]);
#pragma unroll
            for (int db = 0; db < 4; ++db) o[db] = MF32(LDF(sv_ + voffj_(j) + db * 4096), f, o[db]); }
    }
#undef DA_STEP
#undef GA
#undef GB
#undef MF32
#undef LDF
#undef SBAR
#undef DA_DMA
    DA_WAITV(0);
    __syncthreads();
    l += swap32(l);
    const float inv = 1.0f / l;
    LAS float* comb = (LAS float*)lds;
    if (c == 1) {
#pragma unroll
        for (int db = 0; db < 4; ++db)
#pragma unroll
            for (int r = 0; r < 16; ++r) comb[((rg * 4 + db) * 16 + r) * 64 + lane] = o[db][r] * inv;
    }
    __syncthreads();
    if (c == 0) {
        const float lam_l = ((const LAS float*)(lds + LUT_OFF + 1024))[128];
        float ss = 0.f;
#pragma unroll
        for (int db = 0; db < 4; ++db)
#pragma unroll
            for (int r = 0; r < 16; ++r) { const float y = o[db][r] * inv - lam_l * comb[((rg * 4 + db) * 16 + r) * 64 + lane]; o[db][r] = y; ss += y * y; }
        ss += swap32(ss);
        const float rs = 1.0f / sqrtf(ss * (1.0f / 128.0f) + RMS_EPS);
        bf16* op = O + (tok0 + q) * DM + h * 128 + 4 * hi;
        const LAS float* gl = (const LAS float*)(lds + LUT_OFF + 1024);
#pragma unroll
        for (int db = 0; db < 4; ++db)
#pragma unroll
            for (int j = 0; j < 4; ++j) { const f32x4 g = *(const LAS f32x4*)(gl + 32 * db + 8 * j + 4 * hi);
                u32x2 w; w.x = cvtpk(o[db][4 * j + 0] * rs * g.x, o[db][4 * j + 1] * rs * g.y); w.y = cvtpk(o[db][4 * j + 2] * rs * g.z, o[db][4 * j + 3] * rs * g.w);
                *(u32x2*)(op + 32 * db + 8 * j) = w; }
    }
    __syncthreads();
}
}

namespace sbattn {
constexpr int NUNITS = BATCH * 16 * 256;
__device__ __forceinline__ void unit(int b, int h, int qblk, const bf16* __restrict__ Q, const bf16* __restrict__ K, const bf16* __restrict__ VT, bf16* __restrict__ O, LAS unsigned char* wl) {
    int tid_ = threadIdx.x; asm volatile("" : "+v"(tid_));
    const int lane = tid_ & 63, r32 = lane & 31, hi = lane >> 5;
    const size_t tok0 = (size_t)b * SEQ;
    const int q = qblk * 32 + r32;
    bf16x8 qf[8];
    { const bf16* qp = Q + (tok0 + q) * DM + h * 128 + 8 * hi;
#pragma unroll
      for (int ks = 0; ks < 8; ++ks) qf[ks] = *(const bf16x8*)(qp + 16 * ks);
#pragma unroll
      for (int ks = 0; ks < 8; ++ks) asm volatile("" : "+v"(qf[ks])); }
    f32x16 o[4];
#pragma unroll
    for (int i = 0; i < 4; ++i) o[i] = f32x16{};
    float carry = 0.f;
    const int kkey = lane >> 4, kch = lane & 15, vd = lane >> 2, vch = lane & 3;
    const bf16* kg = K + (tok0 + kkey) * DM + h * 128 + kch * 8;
    const bf16* vg = VT + ((size_t)(b * 128) * 2048 + h * 128 + vd) * 64 + vch * 8;
    const int kr = kperm(r32);
    int kro[8], vro[2];
#pragma unroll
    for (int ks = 0; ks < 8; ++ks) kro[ks] = kr * 256 + (((2 * ks + hi) ^ (kr & 15)) << 4);
#pragma unroll
    for (int s = 0; s < 2; ++s) vro[s] = 8192 + r32 * 64 + (((2 * s + hi) ^ ((r32 >> 2) & 3)) << 4);
    for (int kt = qblk; kt >= 0; --kt) {
        const int k0 = kt * 32;
        u32x4 kraw[8], vraw[8];
        { const bf16* kp = kg + (size_t)k0 * DM; const bf16* vp = vg + (size_t)(k0 >> 6) * 2048 * 64 + (k0 & 63);
#pragma unroll
          for (int i = 0; i < 8; ++i) kraw[i] = *(const u32x4*)(kp + (size_t)(4 * i) * DM);
#pragma unroll
          for (int i = 0; i < 8; ++i) vraw[i] = *(const u32x4*)(vp + (16 * i) * 64); }
#pragma unroll
        for (int i = 0; i < 8; ++i) { const int key = 4 * i + kkey; *(LAS u32x4*)(wl + key * 256 + ((kch ^ (key & 15)) << 4)) = kraw[i]; }
#pragma unroll
        for (int i = 0; i < 8; ++i) { const int d = 16 * i + vd; *(LAS u32x4*)(wl + 8192 + d * 64 + ((vch ^ ((d >> 2) & 3)) << 4)) = vraw[i]; }
        f32x16 z = f32x16{};
        { bf16x8 kf[8];
#pragma unroll
          for (int ks = 0; ks < 8; ++ks) kf[ks] = *(const LAS bf16x8*)(wl + kro[ks]);
#pragma unroll
          for (int ks = 0; ks < 8; ++ks) z = __builtin_amdgcn_mfma_f32_32x32x16_bf16(kf[ks], qf[ks], z, 0, 0, 0); }
        bf16x8 vf[4][2];
#pragma unroll
        for (int db = 0; db < 4; ++db)
#pragma unroll
            for (int s = 0; s < 2; ++s) vf[db][s] = *(const LAS bf16x8*)(wl + vro[s] + db * 32 * 64);
        float L[16], lz[16];
        float A0 = 0.f, A1 = 0.f;
#pragma unroll
        for (int r = 0; r < 16; ++r) {
            const int key = k0 + 16 * (r >> 3) + 8 * hi + (r & 7);
            const float zz = z[r];
            const float sp = fmaxf(zz, 0.f) + LN2 * __builtin_amdgcn_logf(1.0f + __builtin_amdgcn_exp2f(-LOG2E * fabsf(zz)));
            const bool valid = key < q;
            L[r] = valid ? -sp : 0.f;
            lz[r] = valid ? (zz - sp) : -INFINITY;
            if (r < 8) A0 += L[r]; else A1 += L[r];
        }
        const float B0 = swap32(A0), B1 = swap32(A1);
        const float base0 = hi ? (B1 + A1) : (B0 + A1 + B1);
        const float base1 = hi ? 0.f : B1;
        float a[16];
        { float run = base0 + carry;
#pragma unroll
          for (int i = 7; i >= 0; --i) { a[i] = __builtin_amdgcn_exp2f(LOG2E * (lz[i] + run)); run += L[i]; }
          run = base1 + carry;
#pragma unroll
          for (int i = 15; i >= 8; --i) { a[i] = __builtin_amdgcn_exp2f(LOG2E * (lz[i] + run)); run += L[i]; } }
        carry += (A0 + A1) + (B0 + B1);
        bf16x8 pf[2];
#pragma unroll
        for (int s = 0; s < 2; ++s) { u32x4 w; w.x = cvtpk(a[8 * s + 0], a[8 * s + 1]); w.y = cvtpk(a[8 * s + 2], a[8 * s + 3]); w.z = cvtpk(a[8 * s + 4], a[8 * s + 5]); w.w = cvtpk(a[8 * s + 6], a[8 * s + 7]); pf[s] = __builtin_bit_cast(bf16x8, w); }
#pragma unroll
        for (int db = 0; db < 4; ++db)
#pragma unroll
            for (int s = 0; s < 2; ++s) o[db] = __builtin_amdgcn_mfma_f32_32x32x16_bf16(vf[db][s], pf[s], o[db], 0, 0, 0);
        if (__all(carry < -105.0f)) break;
    }
    bf16* op = O + (tok0 + q) * DM + h * 128 + 4 * hi;
#pragma unroll
    for (int db = 0; db < 4; ++db)
#pragma unroll
        for (int j = 0; j < 4; ++j) { u32x2 w; w.x = cvtpk(o[db][4 * j + 0], o[db][4 * j + 1]); w.y = cvtpk(o[db][4 * j + 2], o[db][4 * j + 3]); *(u32x2*)(op + 32 * db + 8 * j) = w; }
}
}

#define XB_TMO      128
#define XB_XCNT(j)  (256  + 64 * (j))
#define XB_XSUB(j)  (1280 + 64 * (j))
#define XB_XGEN(j)  (2304 + 64 * (j))
#define XB_TOP      3328
#define XB_TOPGEN   3392
#define XCD_BAR_WORDS 3456
#define XB_SPIN_CAP (1u << 18)

__device__ __forceinline__ unsigned xb_ld(unsigned* p)              { return __hip_atomic_load(p, __ATOMIC_RELAXED, __HIP_MEMORY_SCOPE_AGENT); }
__device__ __forceinline__ unsigned xb_add(unsigned* p, unsigned v) { return __hip_atomic_fetch_add(p, v, __ATOMIC_RELAXED, __HIP_MEMORY_SCOPE_AGENT); }
__device__ __forceinline__ unsigned xb_xcc_id() { return (unsigned)__builtin_amdgcn_s_getreg((3 << 11) | 20) & 0xFu; }
#define XB_SPIN(cond, bar) do { unsigned _sp = 0; while (cond) { __builtin_amdgcn_s_sleep(1); \
    if ((++_sp & 255u) == 0u) { if (xb_ld(&(bar)[XB_TMO])) break; if (_sp > XB_SPIN_CAP) { atomicAdd(&(bar)[XB_TMO], 1u); break; } } } } while (0)

struct XcdBarrier {
    unsigned* bar; unsigned x;
    volatile LAS unsigned* st;
};

__device__ __forceinline__ XcdBarrier xcd_barrier_post(unsigned* bar, volatile LAS unsigned* st) {
    XcdBarrier b; b.bar = bar; b.x = xb_xcc_id(); b.st = st;
    if (threadIdx.x == 0) (void)xb_add(&bar[XB_XCNT(b.x)], 1u);
    return b;
}
__device__ __forceinline__ void xcd_barrier_complete(unsigned* bar, unsigned x, unsigned& nloc, unsigned& nx) {
    const unsigned G = gridDim.x * gridDim.y * gridDim.z;
    unsigned sum, cnt, mine, sp = 0u;
    for (;;) {
        sum = 0u; cnt = 0u; mine = 0u;
#pragma unroll
        for (unsigned j = 0; j < 16; ++j) { const unsigned c = xb_ld(&bar[XB_XCNT(j)]); sum += c; cnt += (c > 0u) ? 1u : 0u; mine = (j == x) ? c : mine; }
        if (sum == G) break;
        __builtin_amdgcn_s_sleep(1);
        if ((++sp & 255u) == 0u) { if (xb_ld(&bar[XB_TMO])) break; if (sp > XB_SPIN_CAP) { atomicAdd(&bar[XB_TMO], 1u); break; } }
    }
    nloc = mine > 0u ? mine : 1u; nx = cnt > 0u ? cnt : 1u;
}

__device__ __forceinline__ void xcd_barrier(const XcdBarrier& b) {
    asm volatile("s_waitcnt vmcnt(0)" ::: "memory");
    __syncthreads();
    if (threadIdx.x == 0) {
        unsigned* bar = b.bar;
        __builtin_amdgcn_s_waitcnt(0);
        unsigned nloc = b.st[0], nx = b.st[1];
        if (nloc == 0u) { xcd_barrier_complete(bar, b.x, nloc, nx); b.st[0] = nloc; b.st[1] = nx; }
        const unsigned old = xb_add(&bar[XB_XSUB(b.x)], 1u);
        const unsigned gen = old / nloc;
        if (old + 1u == (gen + 1u) * nloc) {
            __builtin_amdgcn_fence(__ATOMIC_RELEASE, "agent");
            asm volatile("s_waitcnt vmcnt(0)" ::: "memory");
            const unsigned og = xb_add(&bar[XB_TOP], 1u);
            const unsigned tg = og / nx;
            if (og + 1u == (tg + 1u) * nx) xb_add(&bar[XB_TOPGEN], 1u);
            else XB_SPIN(xb_ld(&bar[XB_TOPGEN]) == tg, bar);
            __builtin_amdgcn_fence(__ATOMIC_ACQUIRE, "agent");
            xb_add(&bar[XB_XGEN(b.x)], 1u);
            asm volatile("s_waitcnt vmcnt(0)" ::: "memory");
        } else {
            XB_SPIN(xb_ld(&bar[XB_XGEN(b.x)]) == gen, bar);
            __builtin_amdgcn_fence(__ATOMIC_ACQUIRE, "agent");
            asm volatile("s_waitcnt vmcnt(0)" ::: "memory");
        }
    }
    __syncthreads();
}

struct Args {
    const float* x; const float* rel_bias; const float* attn_g; const float* ffn_g; const float* w_qkv; const float* w_o;
    const float* lq1; const float* lk1; const float* lq2; const float* lk2; const float* subln_g; const float* kv_g;
    const float* w_kv; const float* w_sq; const float* w_so; const float* w_gate; const float* w_up; const float* w_down; const float* final_g;
    float* out; unsigned char* ws;
};

__global__ void __launch_bounds__(NTHREADS, 2) yoco_fwd(Args a) {
    extern __shared__ __attribute__((aligned(16))) unsigned char lds_raw[];
    cg::grid_group grid = cg::this_grid();
    LAS unsigned char* lds = (LAS unsigned char*)lds_raw;
    const int wave = __builtin_amdgcn_readfirstlane(threadIdx.x >> 6);
    const int G = gridDim.x, bx = blockIdx.x;
    const int gw = bx * NWAVES + wave, ngw = G * NWAVES;
    unsigned char* ws = a.ws;
    volatile LAS unsigned* xb_st = (volatile LAS unsigned*)(lds + 131072 + 15360);
    if (threadIdx.x < 2) xb_st[threadIdx.x] = 0u;
    __syncthreads();
    const XcdBarrier xbar = xcd_barrier_post((unsigned*)(ws + 4096), xb_st);
    bf16* Wqkv_t = (bf16*)(ws + WS_WQKV); bf16* Wo_t = (bf16*)(ws + WS_WO); bf16* Wkv_t = (bf16*)(ws + WS_WKV); bf16* Wsq_t = (bf16*)(ws + WS_WSQ); bf16* Wso_t = (bf16*)(ws + WS_WSO);
    bf16* Wgu_t = (bf16*)(ws + WS_WGU); bf16* Wd_t = (bf16*)(ws + WS_WD);
    bf16* XN = (bf16*)(ws + WS_XN); bf16* QB = (bf16*)(ws + WS_BIG); bf16* KB = QB + (size_t)MTOK * DM; bf16* VTB = KB + (size_t)MTOK * DM; bf16* MID = QB;
    bf16* KS = (bf16*)(ws + WS_KS); bf16* VTS = (bf16*)(ws + WS_VTS); bf16* XH = (bf16*)(ws + WS_XH);
    LAS float* RT = (LAS float*)(lds + 131072);
    float* SSQ = (float*)(ws + WS_SSQ);

    {
        LAS float* scr = (LAS float*)(lds + wave * 16384);
        const int lane = fresh_tid() & 63;
        constexpr int I_QKV = 32 * 192, I_SQ = 32 * 64, I_KV = 32 * 128, I_G = 32 * 176, I_D = 88 * 64;
        constexpr int NITEMS = 2 * I_QKV + 2 * I_SQ + I_KV + 4 * I_SQ + 4 * (2 * I_G + I_D);
        for (int it = gw; it < NITEMS; it += ngw) {
            int r = it;
            if (r < 2 * I_QKV) { const int l = r / I_QKV; transpose_item(a.w_qkv + (size_t)l * DM * 6144, DM, 6144, Wqkv_t + (size_t)l * 6144 * DM, 0, scr, r % I_QKV, lane, a.attn_g + l * DM); continue; } r -= 2 * I_QKV;
            if (r < 2 * I_SQ) { const int l = r / I_SQ; transpose_item(a.w_o + (size_t)l * DM * DM, DM, DM, Wo_t + (size_t)l * DM * DM, 0, scr, r % I_SQ, lane); continue; } r -= 2 * I_SQ;
            if (r < I_KV) { transpose_item(a.w_kv, DM, 4096, Wkv_t, 0, scr, r, lane, a.kv_g); continue; } r -= I_KV;
            if (r < 2 * I_SQ) { const int l = r / I_SQ; transpose_item(a.w_sq + (size_t)l * DM * DM, DM, DM, Wsq_t + (size_t)l * DM * DM, 0, scr, r % I_SQ, lane, a.attn_g + (2 + l) * DM); continue; } r -= 2 * I_SQ;
            if (r < 2 * I_SQ) { const int l = r / I_SQ; transpose_item(a.w_so + (size_t)l * DM * DM, DM, DM, Wso_t + (size_t)l * DM * DM, 0, scr, r % I_SQ, lane); continue; } r -= 2 * I_SQ;
            if (r < 4 * I_G) { const int l = r / I_G; transpose_item(a.w_gate + (size_t)l * DM * FF, DM, FF, Wgu_t + (size_t)l * 2 * FF * DM, 1, scr, r % I_G, lane, a.ffn_g + l * DM); continue; } r -= 4 * I_G;
            if (r < 4 * I_G) { const int l = r / I_G; transpose_item(a.w_up + (size_t)l * DM * FF, DM, FF, Wgu_t + (size_t)l * 2 * FF * DM, 2, scr, r % I_G, lane, a.ffn_g + l * DM); continue; } r -= 4 * I_G;
            { const int l = r / I_D; transpose_item(a.w_down + (size_t)l * FF * DM, FF, DM, Wd_t + (size_t)l * DM * FF, 0, scr, r % I_D, lane); }
        }
        cast_rows(a.x, XH, SSQ, gw, ngw);
    }
    grid.sync();

    for (int l = 0; l < 4; ++l) {
        const bool diff = l < 2;
        const float* hsrc = (l == 0) ? a.x : a.out;
        const float* ssq_a = SSQ + (size_t)(2 * l) * MTOK * 32;
        float* ssq_f = SSQ + (size_t)(2 * l + 1) * MTOK * 32;
        float* ssq_n = SSQ + (size_t)(2 * l + 2) * MTOK * 32;
        {
            pg8::Gemm g{XH, XH, MTOK, DM, DM};
            pg8::MultiOrder S;
            const bf16* Wp = diff ? Wqkv_t + (size_t)l * 6144 * DM : Wsq_t + (size_t)(l - 2) * DM * DM;
            const bf16* Wv = diff ? Wqkv_t + (size_t)l * 6144 * DM + (size_t)4096 * DM : Wkv_t + (size_t)2048 * DM;
            S.s0.init(MTOK, diff ? 4096 : 2048, G, bx); S.A0 = XH; S.B0 = Wp; S.n0 = pg8::MultiOrder::count(S.s0);
            S.s1.init(DM, MTOK, G, bx); S.A1 = Wv; S.B1 = XH; S.n1 = (diff || l == 2) ? pg8::MultiOrder::count(S.s1) : 0;
            S.s2.init(MTOK, DM, G, bx); S.A2 = XH; S.B2 = Wkv_t; S.n2 = (l == 2) ? pg8::MultiOrder::count(S.s2) : 0;
            pg8::build_rtab<false>(RT, ssq_a, S);
            pg8::EpiMulti E{pg8::EpiBf16{QB, DM, 2048, (size_t)MTOK * DM, diff ? 0.125f * LOG2E : 0.08838834764831845f, RT},
                            pg8::EpiVT{diff ? VTB : VTS, RT},
                            pg8::EpiBf16{KS, DM, 0, 0, 1.f, RT}};
            pg8::gemm_phase<pg8::EpiMulti, pg8::MultiOrder, true, true>(lds, g, S, E);
        }
        xcd_barrier(xbar);
        if (diff) {
            const float lam_init = (l == 0) ? 0.2f : 0.35550906759f;
            float lam;
            const int tid = fresh_tid(), lane = tid & 63;
            { const float p1 = a.lq1[l * 64 + lane] * a.lk1[l * 64 + lane], p2 = a.lq2[l * 64 + lane] * a.lk2[l * 64 + lane];
              lam = expf(wave_sum(p1)) - expf(wave_sum(p2)) + lam_init; }
            int curh = -1;
            if (tid < 128) ((LAS float*)(lds + dattn::LUT_OFF + 1024))[tid] = a.subln_g[l * 128 + tid] * (1.0f - lam_init);
            if (tid == 128) ((LAS float*)(lds + dattn::LUT_OFF + 1024))[128] = lam;
            for (int i = 0;; ++i) {
                const int pos = i * G + ((i & 1) ? (G - 1 - bx) : bx);
                if (pos >= dattn::NUNITS) break;
                const int qb = 63 - pos / 32, bh = pos % 32, b = bh >> 4, h = bh & 15;
                if (h != curh) {
                    const int tl = fresh_tid();
                    if (tl < 129) { const int n = tl - 1; int bucket;
                        if (n < 16) bucket = n < 0 ? 0 : n; else { int lg = 16 + (int)(logf((float)n / 16.0f) / 2.0794415416798357f * 16.0f); bucket = lg < 31 ? lg : 31; }
                        const float v = (a.rel_bias[bucket * 16 + h] - a.rel_bias[31 * 16 + h]) * LOG2E;
                        ((LAS float*)(lds + dattn::LUT_OFF))[tl] = (n < 0) ? -INFINITY : v; }
                    curh = h;
                    __syncthreads();
                }
                dattn::unit(b, h, qb, QB, KB, VTB, XN, lds, lam, a.subln_g + l * 128, 1.0f - lam_init);
            }
        } else {
            for (int u = gw; u < sbattn::NUNITS; u += ngw) {
                const int bh = u >> 8, qblk = u & 255;
                sbattn::unit(bh >> 4, bh & 15, qblk, QB, KS, VTS, XN, lds + wave * 16384);
            }
        }
        xcd_barrier(xbar);
        {
            pg8::Gemm g{XN, diff ? Wo_t + (size_t)l * DM * DM : Wso_t + (size_t)(l - 2) * DM * DM, MTOK, DM, DM};
            pg8::StaticOrder S; S.init(g.M, g.N, G, bx);
            pg8::EpiResN E{hsrc, a.out, DM, XH, ssq_f};
            pg8::gemm_phase<pg8::EpiResN, pg8::StaticOrder, true, true>(lds, g, S, E);
        }
        xcd_barrier(xbar);
        {
            pg8::Gemm g{XH, Wgu_t + (size_t)l * 2 * FF * DM, MTOK, 2 * FF, DM};
            pg8::StaticOrder S; S.init(g.M, g.N, G, bx);
            pg8::build_rtab<false>(RT, ssq_f, S);
            pg8::EpiSwiGLU E{MID, FF, RT};
            pg8::gemm_phase<pg8::EpiSwiGLU, pg8::StaticOrder, true, true>(lds, g, S, E);
        }
        xcd_barrier(xbar);
        {
            pg8::Gemm g{MID, Wd_t + (size_t)l * DM * FF, MTOK, DM, FF};
            pg8::StaticOrder S; S.init(g.M, g.N, G, bx);
            pg8::EpiResN E{a.out, a.out, DM, l < 3 ? XH : nullptr, ssq_n};
            pg8::gemm_phase<pg8::EpiResN, pg8::StaticOrder, true, true>(lds, g, S, E);
        }
        xcd_barrier(xbar);
    }
    final_norm(a.out, a.final_g, gw, ngw);
}

extern "C" void kernel_launch(void* const* d_in, const int* in_sizes, int n_in, void* d_out, int out_size, void* d_ws, size_t ws_size, hipStream_t stream) {
    static int grid = 0;
    if (grid == 0) {
        if (n_in != 19 || ws_size < WS_END) { fprintf(stderr, "kernel_launch: unexpected inputs (%d) or workspace (%zu < %zu)\n", n_in, ws_size, (size_t)WS_END); grid = -1; return; }
        int dev = 0, cus = 0, per_cu = 0;
        hipGetDevice(&dev); hipDeviceGetAttribute(&cus, hipDeviceAttributeMultiprocessorCount, dev);
        hipFuncSetAttribute((const void*)yoco_fwd, hipFuncAttributeMaxDynamicSharedMemorySize, LDS_BYTES);
        hipOccupancyMaxActiveBlocksPerMultiprocessor(&per_cu, (const void*)yoco_fwd, NTHREADS, LDS_BYTES);
        (void)hipGetLastError();
        if (per_cu < 1) per_cu = 1;
        grid = cus * per_cu;
    }
    if (grid < 0) return;
    Args a{};
    a.x = (const float*)d_in[0]; a.rel_bias = (const float*)d_in[1]; a.attn_g = (const float*)d_in[2]; a.ffn_g = (const float*)d_in[3]; a.w_qkv = (const float*)d_in[4]; a.w_o = (const float*)d_in[5];
    a.lq1 = (const float*)d_in[6]; a.lk1 = (const float*)d_in[7]; a.lq2 = (const float*)d_in[8]; a.lk2 = (const float*)d_in[9]; a.subln_g = (const float*)d_in[10]; a.kv_g = (const float*)d_in[11];
    a.w_kv = (const float*)d_in[12]; a.w_sq = (const float*)d_in[13]; a.w_so = (const float*)d_in[14]; a.w_gate = (const float*)d_in[15]; a.w_up = (const float*)d_in[16]; a.w_down = (const float*)d_in[17]; a.final_g = (const float*)d_in[18];
    a.out = (float*)d_out; a.ws = (unsigned char*)d_ws;
    hipMemsetAsync((char*)d_ws + 4096, 0, XCD_BAR_WORDS * 4, stream);
    void* args[] = {&a};
    hipError_t e = hipLaunchCooperativeKernel((const void*)yoco_fwd, dim3(grid), dim3(NTHREADS), args, LDS_BYTES, stream);
    if (e != hipSuccess) fprintf(stderr, "cooperative launch failed: %s (grid %d)\n", hipGetErrorString(e), grid);
}
```

```cpp
#include <hip/hip_runtime.h>
#include <hip/hip_cooperative_groups.h>
#include <cstdio>
#include <cstdint>
#include <cmath>
namespace cg = cooperative_groups;
namespace pg8 {
#define PG8_LAS __attribute__((address_space(3)))
typedef unsigned short bf16_t;
typedef short bf16x8 __attribute__((ext_vector_type(8)));
typedef float f32x4 __attribute__((ext_vector_type(4)));
typedef unsigned u32x4 __attribute__((ext_vector_type(4)));
constexpr int BM = 256, BK = 64, HALF = 128, HTB = HALF * BK * 2  , STAGE_BYTES = 8 * HTB, NXCD = 8, WGM = 8;

__host__ __device__ __forceinline__ int lds_byte(int r, int c) { const int st = (r >> 4) * 2 + (c >> 5), rr = r & 15, cc = c & 31, ob = rr * 64 + cc * 2; return st * 1024 + (ob ^ (((ob >> 9) & 1) << 5)); }
__host__ __device__ __forceinline__ void stage_rc(int b, int& R, int& C) { const int st = b / 1024, sb = b % 1024, swz = sb ^ (((sb >> 9) & 1) << 5); R = (st >> 1) * 16 + swz / 64; C = (st & 1) * 32 + (swz % 64) / 2; }
__host__ __device__ __forceinline__ int perm32(int rho) { const int n = rho >> 4, i = rho & 15; return 8 * (i >> 2) + 4 * n + (i & 3); }

struct Unit { int pm, pn; const unsigned short* A = nullptr; const unsigned short* Bt = nullptr; int id = 0; };
struct Gemm { const bf16_t* A; const bf16_t* Bt; int M, N, K; };

struct StaticOrder {
    int nM, nN, nwg, G, c;
    __host__ __device__ void init(int M, int N, int G_, int c_) { nM = M / BM; nN = N / BM; nwg = nM * nN; G = G_; c = c_; }
    __host__ __device__ bool next(int i, Unit& u) const {
        const long L = (long)i * G + c; if (L >= nwg) return false;
        int wgid = (int)L; { const int q = nwg / NXCD, r = nwg % NXCD, xcd = wgid % NXCD, off = wgid / NXCD; wgid = (xcd < r ? xcd * (q + 1) : r * (q + 1) + (xcd - r) * q) + off; }
        const int nig = WGM * nN, gid = wgid / nig, fm = gid * WGM, gsz = (nM - fm) < WGM ? (nM - fm) : WGM;
        u.pm = fm + ((wgid % nig) % gsz); u.pn = (wgid % nig) / gsz; return true;
    }
    __device__ __forceinline__ void a_ready(const Unit&) const {}
    __device__ __forceinline__ void done(const Unit&) const {}
};

__device__ __forceinline__ unsigned cvt_pk_bf16(float lo, float hi) { unsigned r; asm volatile("v_cvt_pk_bf16_f32 %0, %1, %2" : "=v"(r) : "v"(lo), "v"(hi)); return r; }
typedef float f32x2 __attribute__((ext_vector_type(2)));

typedef unsigned u32x2e __attribute__((ext_vector_type(2)));
__device__ __forceinline__ float row_rs(const float* part, int row) {
    const f32x4* p = (const f32x4*)(part + (size_t)row * 32); f32x4 s = p[0];
#pragma unroll
    for (int i = 1; i < 8; ++i) s += p[i];
    return __builtin_amdgcn_rsqf(((s[0] + s[1]) + (s[2] + s[3])) * (1.0f / 2048.0f) + 1e-5f);
}


template <bool COLS, class Sched> __device__ __forceinline__ void build_rtab(PG8_LAS float* tab, const float* part, const Sched& S) {
    int t_ = threadIdx.x; asm volatile("" : "+v"(t_));
    Unit u;
    for (int i = 0; i < 14 && S.next(i, u); ++i) { const int base = ((COLS || u.id == 1) ? u.pn : u.pm) * BM; if (t_ < 256) tab[i * 256 + t_] = row_rs(part, base + t_); }
    __syncthreads();
}
struct EpiBf16 {
    static constexpr bool PERM = true, AFTER_DRAIN = false;
    bf16_t* O; int ldc; int split_cols; size_t split_stride; float scale0; const PG8_LAS float* rtab;
    __device__ __forceinline__ void operator()(const f32x4 (&acc)[2][2][4][2], const Unit& u, int ui, int wr, int wc, int fr, int fq) const {
        const int row0 = u.pm * BM + wr * 64 + fr; int colt = u.pn * BM; bf16_t* base = O;
        float sc = 1.f; if (split_cols) { const int t = colt / split_cols; base += (size_t)t * split_stride; colt -= t * split_cols; if (t == 0) sc = scale0; }
        const int col0 = colt + wc * 32 + 8 * fq;
#pragma unroll
        for (int ai = 0; ai < 2; ++ai)
#pragma unroll
            for (int m = 0; m < 4; ++m) { bf16_t* rowp = base + (size_t)(row0 + ai * HALF + m * 16) * ldc + col0;
                const float rsc = sc * rtab[ui * 256 + wr * 64 + fr + ai * HALF + m * 16];
#pragma unroll
                for (int bj = 0; bj < 2; ++bj) { f32x4 v0 = acc[ai][bj][m][0] * rsc, v1 = acc[ai][bj][m][1] * rsc;
                    u32x4 w; w.x = cvt_pk_bf16(v0[0], v0[1]); w.y = cvt_pk_bf16(v0[2], v0[3]); w.z = cvt_pk_bf16(v1[0], v1[1]); w.w = cvt_pk_bf16(v1[2], v1[3]);
                    *(u32x4*)(rowp + bj * HALF) = w; } }
    }
};
struct EpiRes {
    static constexpr bool PERM = false, AFTER_DRAIN = false;
    const float* base; float* out; int ldc;
    __device__ __forceinline__ void operator()(const f32x4 (&acc)[2][2][4][2], const Unit& u, int ui, int wr, int wc, int fr, int fq) const {
        const int col0 = u.pn * BM + wc * 32 + 4 * fq;
#pragma unroll
        for (int ai = 0; ai < 2; ++ai)
#pragma unroll
            for (int m = 0; m < 4; ++m) { const size_t off = (size_t)(u.pm * BM + ai * HALF + wr * 64 + m * 16 + fr) * ldc + col0;
#pragma unroll
                for (int bj = 0; bj < 2; ++bj)
#pragma unroll
                    for (int n = 0; n < 2; ++n) { const f32x4 bs = *(const f32x4*)(base + off + bj * HALF + n * 16); *(f32x4*)(out + off + bj * HALF + n * 16) = bs + acc[ai][bj][m][n]; } }
    }
};
struct EpiSwiGLU {
    static constexpr bool PERM = true, AFTER_DRAIN = false;
    bf16_t* O; int ldc; const PG8_LAS float* rtab;
    __device__ __forceinline__ static float silu_mul(float g, float u) { return g * u * __builtin_amdgcn_rcpf(1.0f + __builtin_amdgcn_exp2f(-1.4426950408889634f * g)); }
    __device__ __forceinline__ void operator()(const f32x4 (&acc)[2][2][4][2], const Unit& u, int ui, int wr, int wc, int fr, int fq) const {
        const int row0 = u.pm * BM + wr * 64 + fr; const int col0 = u.pn * HALF + wc * 32 + 8 * fq;
#pragma unroll
        for (int ai = 0; ai < 2; ++ai)
#pragma unroll
            for (int m = 0; m < 4; ++m) { bf16_t* rowp = O + (size_t)(row0 + ai * HALF + m * 16) * ldc + col0;
                const float rsc = rtab[ui * 256 + wr * 64 + fr + ai * HALF + m * 16];
                const f32x4 g0 = acc[ai][0][m][0] * rsc, g1 = acc[ai][0][m][1] * rsc, u0 = acc[ai][1][m][0] * rsc, u1 = acc[ai][1][m][1] * rsc;
                u32x4 w; w.x = cvt_pk_bf16(silu_mul(g0[0], u0[0]), silu_mul(g0[1], u0[1])); w.y = cvt_pk_bf16(silu_mul(g0[2], u0[2]), silu_mul(g0[3], u0[3]));
                w.z = cvt_pk_bf16(silu_mul(g1[0], u1[0]), silu_mul(g1[1], u1[1])); w.w = cvt_pk_bf16(silu_mul(g1[2], u1[2]), silu_mul(g1[3], u1[3]));
                *(u32x4*)rowp = w; }
    }
};

struct EpiVT {
    static constexpr bool PERM = true, AFTER_DRAIN = false;
    bf16_t* O; const PG8_LAS float* rtab;
    __device__ __forceinline__ void operator()(const f32x4 (&acc)[2][2][4][2], const Unit& u, int ui, int wr, int wc, int fr, int fq) const {
        const int row0 = u.pm * BM + wr * 64 + fr; const int col0 = u.pn * BM + wc * 32 + 8 * fq;
        f32x4 cs[2][2];
#pragma unroll
        for (int bj = 0; bj < 2; ++bj)
#pragma unroll
            for (int n = 0; n < 2; ++n) cs[bj][n] = *(const PG8_LAS f32x4*)(rtab + ui * 256 + wc * 32 + 8 * fq + bj * HALF + 4 * n);
#pragma unroll
        for (int ai = 0; ai < 2; ++ai)
#pragma unroll
            for (int m = 0; m < 4; ++m) { const int ch = row0 + ai * HALF + m * 16;
#pragma unroll
                for (int bj = 0; bj < 2; ++bj) { const int col = col0 + bj * HALF; const f32x4 v0 = acc[ai][bj][m][0] * cs[bj][0], v1 = acc[ai][bj][m][1] * cs[bj][1];
                    u32x4 w; w.x = cvt_pk_bf16(v0[0], v0[1]); w.y = cvt_pk_bf16(v0[2], v0[3]); w.z = cvt_pk_bf16(v1[0], v1[1]); w.w = cvt_pk_bf16(v1[2], v1[3]);
                    *(u32x4*)(O + ((size_t)(col >> 6) * 2048 + ch) * 64 + (col & 63)) = w; } }
    }
};

struct EpiResN {
    static constexpr bool PERM = false, AFTER_DRAIN = false;
    const float* base; float* out; int ldc; bf16_t* XH; float* ssq;
    __device__ __forceinline__ void operator()(const f32x4 (&acc)[2][2][4][2], const Unit& u, int ui, int wr, int wc, int fr, int fq) const {
        const int col0 = u.pn * BM + wc * 32 + 4 * fq; const int rowb = u.pm * BM + wr * 64 + fr;
        f32x4 nxt[2][2];
#pragma unroll
        for (int bj = 0; bj < 2; ++bj)
#pragma unroll
            for (int n = 0; n < 2; ++n) nxt[bj][n] = *(const f32x4*)(base + (size_t)rowb * ldc + col0 + bj * HALF + n * 16);
#pragma unroll
        for (int g = 0; g < 8; ++g) { const int ai = g >> 2, m = g & 3; const int row = rowb + ai * HALF + m * 16; const size_t off = (size_t)row * ldc + col0;
            f32x4 cur[2][2];
#pragma unroll
            for (int bj = 0; bj < 2; ++bj)
#pragma unroll
                for (int n = 0; n < 2; ++n) cur[bj][n] = nxt[bj][n];
            if (g + 1 < 8) { const int row2 = rowb + ((g + 1) >> 2) * HALF + ((g + 1) & 3) * 16;
#pragma unroll
                for (int bj = 0; bj < 2; ++bj)
#pragma unroll
                    for (int n = 0; n < 2; ++n) nxt[bj][n] = *(const f32x4*)(base + (size_t)row2 * ldc + col0 + bj * HALF + n * 16); }
            float ss = 0.f;
#pragma unroll
            for (int bj = 0; bj < 2; ++bj)
#pragma unroll
                for (int n = 0; n < 2; ++n) { const f32x4 v = cur[bj][n] + acc[ai][bj][m][n]; *(f32x4*)(out + off + bj * HALF + n * 16) = v;
                    if (XH) { u32x2e w; w.x = cvt_pk_bf16(v[0], v[1]); w.y = cvt_pk_bf16(v[2], v[3]); *(u32x2e*)(XH + off + bj * HALF + n * 16) = w; }
                    ss += (v[0] * v[0] + v[1] * v[1]) + (v[2] * v[2] + v[3] * v[3]); }
            if (XH) {
            ss += __int_as_float(__builtin_amdgcn_ds_swizzle(__float_as_int(ss), (16 << 10) | 0x1f));
            { auto rr = __builtin_amdgcn_permlane32_swap(__float_as_uint(ss), __float_as_uint(ss), false, false); ss = __uint_as_float(rr[0]) + __uint_as_float(rr[1]); }
            if (fq == 0) ssq[(size_t)row * 32 + u.pn * 4 + wc] = ss; } }
    }
};

struct MultiOrder {
    StaticOrder s0, s1, s2; const bf16_t *A0, *B0, *A1, *B1, *A2, *B2; int n0, n1, n2;
    __device__ __forceinline__ static int count(const StaticOrder& s) { return s.nwg > s.c ? (s.nwg - s.c + s.G - 1) / s.G : 0; }
    __device__ __forceinline__ bool next(int i, Unit& u) const {
        if (i < n0) { s0.next(i, u); u.A = A0; u.Bt = B0; u.id = 0; return true; } i -= n0;
        if (i < n1) { s1.next(i, u); u.A = A1; u.Bt = B1; u.id = 1; return true; } i -= n1;
        if (i < n2) { s2.next(i, u); u.A = A2; u.Bt = B2; u.id = 2; return true; }
        return false;
    }
    __device__ __forceinline__ void a_ready(const Unit&) const {}
    __device__ __forceinline__ void done(const Unit&) const {}
};
struct EpiMulti {
    static constexpr bool PERM = true, AFTER_DRAIN = false;
    EpiBf16 e0; EpiVT e1; EpiBf16 e2;
    __device__ __forceinline__ void operator()(const f32x4 (&acc)[2][2][4][2], const Unit& u, int ui, int wr, int wc, int fr, int fq) const {
        if (u.id == 0) e0(acc, u, ui, wr, wc, fr, fq); else if (u.id == 1) e1(acc, u, ui, wr, wc, fr, fq); else e2(acc, u, ui, wr, wc, fr, fq);
    }
};

template <class Epi, class Sched, bool ALIGN_EPI = false, bool SP2 = false>
__device__ __forceinline__ void gemm_phase(PG8_LAS unsigned char* lds, const Gemm g, const Sched& S, const Epi& E) {
    int tid_ = threadIdx.x; asm volatile("" : "+v"(tid_));
    const int tid = tid_, wid = __builtin_amdgcn_readfirstlane(tid >> 6), lane = tid & 63, wr = wid >> 2, wc = wid & 3, fr = lane & 15, fq = lane >> 4;
    const int K = g.K, nt = K / BK;
    unsigned voffA[2], voffB[2];
#pragma unroll
    for (int i = 0; i < 2; ++i) { int R, C; stage_rc(tid * 16 + i * 8192, R, C); const int Rb = Epi::PERM ? ((R & ~31) + perm32(R & 31)) : R;
        voffA[i] = (unsigned)(R * K + C) * 2u; voffB[i] = (unsigned)(Rb * K + C) * 2u; }
    const size_t kstep = (size_t)(BK * 2);
    const size_t hstep = (size_t)HALF * K * 2;
    const size_t tstep = 2 * hstep;
    const unsigned ldsw = (unsigned)wid * 1024u;
    const int aoff = lds_byte(wr * 64 + fr, fq * 8), boff = lds_byte(wc * 32 + fr, fq * 8);
#define PG8_SA(b, h) (((b) * 2 + (h)) * HTB)
#define PG8_SB(b, h) ((4 + (b) * 2 + (h)) * HTB)
#define PG8_STAGE(bufoff, gbase, voff) do { _Pragma("unroll") for (int _i = 0; _i < 2; ++_i) \
        __builtin_amdgcn_global_load_lds((const unsigned*)((const char*)(gbase) + (voff)[_i]), (PG8_LAS unsigned*)(lds + (bufoff) + ldsw + _i * 8192), 16, 0, 0); } while (0)
#define PG8_LDA(dst, b, h) do { _Pragma("unroll") for (int m = 0; m < 4; ++m) _Pragma("unroll") for (int k = 0; k < 2; ++k) dst[m][k] = *(const PG8_LAS bf16x8*)(lds + PG8_SA(b, h) + aoff + m * 2048 + k * 1024); } while (0)
#define PG8_LDB(dst, b, h) do { _Pragma("unroll") for (int n = 0; n < 2; ++n) _Pragma("unroll") for (int k = 0; k < 2; ++k) dst[n][k] = *(const PG8_LAS bf16x8*)(lds + PG8_SB(b, h) + boff + n * 2048 + k * 1024); } while (0)
#define PG8_MMA(ai, bj, At, Bt) do { __builtin_amdgcn_s_setprio(1); _Pragma("unroll") for (int m = 0; m < 4; ++m) _Pragma("unroll") for (int n = 0; n < 2; ++n) _Pragma("unroll") for (int k = 0; k < 2; ++k) \
        acc[ai][bj][m][n] = __builtin_amdgcn_mfma_f32_16x16x32_bf16(Bt[n][k], At[m][k], acc[ai][bj][m][n], 0, 0, 0); __builtin_amdgcn_s_setprio(0); } while (0)
#define PG8_WAIT_V(n) asm volatile("s_waitcnt vmcnt(" #n ")" ::: "memory")
#define PG8_WAIT_L(n) asm volatile("s_waitcnt lgkmcnt(" #n ")" ::: "memory")
#define PG8_BAR __builtin_amdgcn_s_barrier()
#define PG8_SCHED __builtin_amdgcn_sched_barrier(0)
    Unit cur, nxt; int ui = 0;
    if (!S.next(0, cur)) return;
    f32x4 acc[2][2][4][2];
#pragma unroll
    for (int a = 0; a < 2; ++a)
#pragma unroll
        for (int b = 0; b < 2; ++b)
#pragma unroll
            for (int m = 0; m < 4; ++m)
#pragma unroll
                for (int n = 0; n < 2; ++n) acc[a][b][m][n] = (f32x4){0.f, 0.f, 0.f, 0.f};
    bf16x8 At[4][2], B0[2][2], B1[2][2];
    const char* cA = (const char*)(cur.A ? cur.A : g.A) + (size_t)cur.pm * tstep; const char* cB = (const char*)(cur.Bt ? cur.Bt : g.Bt) + (size_t)cur.pn * tstep;
    S.a_ready(cur);
    if constexpr (SP2) {
        PG8_STAGE(PG8_SB(0, 0), cB, voffB); PG8_STAGE(PG8_SB(0, 1), cB + hstep, voffB); PG8_STAGE(PG8_SA(0, 0), cA, voffA); PG8_STAGE(PG8_SA(0, 1), cA + hstep, voffA);
        if (wr == 1) PG8_BAR;
        PG8_WAIT_V(2); PG8_BAR;
        PG8_STAGE(PG8_SB(1, 0), cB + kstep, voffB); PG8_STAGE(PG8_SA(1, 0), cA + kstep, voffA); PG8_STAGE(PG8_SB(1, 1), cB + hstep + kstep, voffB);
        PG8_WAIT_V(6); PG8_BAR;
    } else {
        PG8_STAGE(PG8_SB(0, 0), cB, voffB); PG8_STAGE(PG8_SA(0, 0), cA, voffA); PG8_STAGE(PG8_SB(0, 1), cB + hstep, voffB); PG8_STAGE(PG8_SA(0, 1), cA + hstep, voffA);
        if (wr == 1) PG8_BAR;
        PG8_WAIT_V(4); PG8_BAR;
        PG8_STAGE(PG8_SB(1, 0), cB + kstep, voffB); PG8_STAGE(PG8_SA(1, 0), cA + kstep, voffA); PG8_STAGE(PG8_SB(1, 1), cB + hstep + kstep, voffB);
        PG8_WAIT_V(6); PG8_BAR;
    }
    for (;;) {
        const bool has_next = S.next(ui + 1, nxt);
        const char* nA = has_next ? (const char*)(nxt.A ? nxt.A : g.A) + (size_t)nxt.pm * tstep : cA; const char* nB = has_next ? (const char*)(nxt.Bt ? nxt.Bt : g.Bt) + (size_t)nxt.pn * tstep : cB;
        for (int t = 0; t < nt; t += 2) {
            const bool last = (t == nt - 2);
            const char* a1 = cA + (size_t)(t + 1) * kstep;
            const char* a2 = last ? nA : cA + (size_t)(t + 2) * kstep; const char* b2 = last ? nB : cB + (size_t)(t + 2) * kstep;
            const char* a3 = a2 + kstep; const char* b3 = b2 + kstep;
            if (last && has_next) S.a_ready(nxt);
            if constexpr (SP2) {
            PG8_LDB(B0, 0, 0); PG8_LDB(B1, 0, 1); PG8_SCHED; PG8_LDA(At, 0, 0); PG8_STAGE(PG8_SA(1, 1), a1 + hstep, voffA);
            PG8_WAIT_V(8); PG8_WAIT_L(0); PG8_BAR; PG8_MMA(0, 0, At, B0); PG8_MMA(0, 1, At, B1); PG8_BAR; PG8_SCHED;
            PG8_LDA(At, 0, 1); PG8_STAGE(PG8_SB(0, 0), b2, voffB); PG8_STAGE(PG8_SB(0, 1), b2 + hstep, voffB); PG8_STAGE(PG8_SA(0, 0), a2, voffA);
            PG8_WAIT_V(8); PG8_WAIT_L(0); PG8_BAR; PG8_MMA(1, 0, At, B0); PG8_MMA(1, 1, At, B1); PG8_BAR; PG8_SCHED;
            PG8_LDB(B0, 1, 0); PG8_LDB(B1, 1, 1); PG8_SCHED; PG8_LDA(At, 1, 0); PG8_STAGE(PG8_SA(0, 1), a2 + hstep, voffA);
            PG8_WAIT_V(8); PG8_WAIT_L(0); PG8_BAR; PG8_MMA(0, 0, At, B0); PG8_MMA(0, 1, At, B1); PG8_BAR; PG8_SCHED;
            PG8_LDA(At, 1, 1); PG8_STAGE(PG8_SB(1, 0), b3, voffB); PG8_STAGE(PG8_SB(1, 1), b3 + hstep, voffB); PG8_STAGE(PG8_SA(1, 0), a3, voffA);
            PG8_WAIT_V(8); PG8_WAIT_L(0); PG8_BAR; PG8_MMA(1, 0, At, B0); PG8_MMA(1, 1, At, B1); PG8_BAR; PG8_SCHED;
            } else {
            PG8_LDB(B0, 0, 0); PG8_SCHED; PG8_LDA(At, 0, 0); PG8_STAGE(PG8_SA(1, 1), a1 + hstep, voffA);
            PG8_WAIT_L(8); PG8_BAR; PG8_WAIT_L(0); PG8_MMA(0, 0, At, B0); PG8_BAR; PG8_SCHED;
            PG8_LDB(B1, 0, 1); PG8_STAGE(PG8_SB(0, 0), b2, voffB);
            PG8_BAR; PG8_WAIT_L(0); PG8_MMA(0, 1, At, B1); PG8_BAR;
            PG8_LDA(At, 0, 1); PG8_STAGE(PG8_SA(0, 0), a2, voffA);
            PG8_BAR; PG8_WAIT_L(0); PG8_MMA(1, 0, At, B0); PG8_BAR; PG8_SCHED;
            PG8_STAGE(PG8_SB(0, 1), b2 + hstep, voffB);
            PG8_WAIT_V(6); PG8_BAR; PG8_MMA(1, 1, At, B1); PG8_BAR;
            PG8_LDB(B0, 1, 0); PG8_SCHED; PG8_LDA(At, 1, 0); PG8_STAGE(PG8_SA(0, 1), a2 + hstep, voffA);
            PG8_WAIT_L(8); PG8_BAR; PG8_WAIT_L(0); PG8_MMA(0, 0, At, B0); PG8_BAR; PG8_SCHED;
            PG8_LDB(B1, 1, 1); PG8_STAGE(PG8_SB(1, 0), b3, voffB);
            PG8_BAR; PG8_WAIT_L(0); PG8_MMA(0, 1, At, B1); PG8_BAR;
            PG8_LDA(At, 1, 1); PG8_STAGE(PG8_SA(1, 0), a3, voffA);
            PG8_BAR; PG8_WAIT_L(0); PG8_MMA(1, 0, At, B0); PG8_BAR; PG8_SCHED;
            PG8_STAGE(PG8_SB(1, 1), b3 + hstep, voffB);
            PG8_WAIT_V(6); PG8_BAR; PG8_MMA(1, 1, At, B1); PG8_BAR;
            }
        }
        if constexpr (ALIGN_EPI) { if (wr == 0) PG8_BAR; }
        if constexpr (!Epi::AFTER_DRAIN) { E(acc, cur, ui, wr, wc, fr, fq); S.done(cur); }
        if (!has_next) break;
#pragma unroll
        for (int a = 0; a < 2; ++a)
#pragma unroll
            for (int b = 0; b < 2; ++b)
#pragma unroll
                for (int m = 0; m < 4; ++m)
#pragma unroll
                    for (int n = 0; n < 2; ++n) acc[a][b][m][n] = (f32x4){0.f, 0.f, 0.f, 0.f};
        cur = nxt; cA = nA; cB = nB; ++ui;
        if constexpr (ALIGN_EPI) { if (wr == 1) PG8_BAR; }
    }
    PG8_WAIT_V(0);
    if constexpr (!ALIGN_EPI) { if (wr == 0) PG8_BAR; }
    PG8_BAR;
    if constexpr (Epi::AFTER_DRAIN) { E.fused(acc, cur, wr, wc, fr, fq, lds, wid, lane); S.done(cur); }
#undef PG8_SA
#undef PG8_SB
#undef PG8_STAGE
#undef PG8_LDA
#undef PG8_LDB
#undef PG8_MMA
#undef PG8_WAIT_V
#undef PG8_WAIT_L
#undef PG8_BAR
#undef PG8_SCHED
}
}

#define LAS __attribute__((address_space(3)))
typedef unsigned short bf16;
typedef short bf16x8 __attribute__((ext_vector_type(8)));
typedef float f32x4 __attribute__((ext_vector_type(4)));
typedef float f32x16 __attribute__((ext_vector_type(16)));
typedef unsigned u32x4 __attribute__((ext_vector_type(4)));
typedef unsigned u32x2 __attribute__((ext_vector_type(2)));

constexpr int NWAVES = 8, NTHREADS = 512;
constexpr int BATCH = 2, SEQ = 8192, DM = 2048, FF = 5632, MTOK = BATCH * SEQ;
constexpr float RMS_EPS = 1e-5f;
constexpr float LOG2E = 1.4426950408889634f, LN2 = 0.6931471805599453f;
constexpr int LDS_BYTES = 147456;

constexpr size_t MiB = 1u << 20;
constexpr size_t WS_WQKV = 2 * MiB;
constexpr size_t WS_WO   = WS_WQKV + 48 * MiB;
constexpr size_t WS_WKV  = WS_WO + 16 * MiB;
constexpr size_t WS_WSQ  = WS_WKV + 16 * MiB;
constexpr size_t WS_WSO  = WS_WSQ + 16 * MiB;
constexpr size_t WS_WGU  = WS_WSO + 16 * MiB;
constexpr size_t WS_WD   = WS_WGU + 176 * MiB;
constexpr size_t WS_XN   = WS_WD + 88 * MiB;
constexpr size_t WS_BIG  = WS_XN + 64 * MiB;
constexpr size_t WS_KS   = WS_BIG + 192 * MiB;
constexpr size_t WS_VTS  = WS_KS + 64 * MiB;
constexpr size_t WS_XH   = WS_VTS + 64 * MiB;
constexpr size_t WS_SSQ  = WS_XH + 64 * MiB;
constexpr size_t WS_END  = WS_SSQ + 18 * MiB;

__device__ __forceinline__ int fresh_tid() { int t = threadIdx.x; asm volatile("" : "+v"(t)); return t; }
#define SWZ_XOR(v, k) __int_as_float(__builtin_amdgcn_ds_swizzle(__float_as_int(v), ((k) << 10) | 0x1f))
__device__ __forceinline__ float wave_sum(float v) {
    v += SWZ_XOR(v, 1); v += SWZ_XOR(v, 2); v += SWZ_XOR(v, 4); v += SWZ_XOR(v, 8); v += SWZ_XOR(v, 16);
    auto rr = __builtin_amdgcn_permlane32_swap(__float_as_uint(v), __float_as_uint(v), false, false);
    return __uint_as_float(rr[0]) + __uint_as_float(rr[1]);
}
__device__ __forceinline__ unsigned cvtpk(float lo, float hi) { unsigned r; asm volatile("v_cvt_pk_bf16_f32 %0, %1, %2" : "=v"(r) : "v"(lo), "v"(hi)); return r; }
__device__ __forceinline__ float swap32(float v) {
    auto rr = __builtin_amdgcn_permlane32_swap(__float_as_uint(v), __float_as_uint(v), false, false);
    return (threadIdx.x & 32) ? __uint_as_float(rr[0]) : __uint_as_float(rr[1]);
}

__device__ __forceinline__ void transpose_item(const float* W, int K, int N, bf16* WT, int mode, LAS float* scr, int item, int lane, const float* gain = nullptr) {
    const int nblk = N / 32, kb = item / nblk, nb = item % nblk, k0 = 64 * kb, n0 = 32 * nb;
    int drow = n0;
    if (mode == 1) drow = 256 * (n0 >> 7) + (n0 & 127);
    if (mode == 2) drow = 256 * (n0 >> 7) + 128 + (n0 & 127);
    {
        f32x4 wv[8];
#pragma unroll
        for (int i = 0; i < 8; ++i) { const int f = i * 64 + lane; wv[i] = __builtin_nontemporal_load((const f32x4*)(W + (size_t)(k0 + (f >> 3)) * N + n0 + (f & 7) * 4)); }
#pragma unroll
        for (int i = 0; i < 8; ++i) { const int f = i * 64 + lane; LAS float* d = scr + (f >> 3) * 33 + (f & 7) * 4; d[0] = wv[i].x; d[1] = wv[i].y; d[2] = wv[i].z; d[3] = wv[i].w; }
    }
    asm volatile("s_waitcnt lgkmcnt(0)" ::: "memory");
    const int c = lane & 7;
    f32x4 ga = (f32x4){1.f, 1.f, 1.f, 1.f}, gb = ga;
    if (gain) { ga = *(const f32x4*)(gain + k0 + 8 * c); gb = *(const f32x4*)(gain + k0 + 8 * c + 4); }
#pragma unroll
    for (int j = 0; j < 4; ++j) { const int n = (lane >> 3) + 8 * j; const LAS float* s = scr + (8 * c) * 33 + n;
        u32x4 o; o.x = cvtpk(s[0 * 33] * ga.x, s[1 * 33] * ga.y); o.y = cvtpk(s[2 * 33] * ga.z, s[3 * 33] * ga.w); o.z = cvtpk(s[4 * 33] * gb.x, s[5 * 33] * gb.y); o.w = cvtpk(s[6 * 33] * gb.z, s[7 * 33] * gb.w);
        *(u32x4*)(WT + (size_t)(drow + n) * K + k0 + 8 * c) = o; }
    asm volatile("s_waitcnt lgkmcnt(0)" ::: "memory");
}

__device__ __forceinline__ void norm_rows(const float* src, const float* g1, bf16* d1, const float* g2, bf16* d2, int gw, int ngw) {
    const int lane = fresh_tid() & 63;
    for (int m = gw; m < MTOK; m += ngw) {
        const f32x4* xr = (const f32x4*)(src + (size_t)m * DM) + lane;
        f32x4 v[8]; float s = 0.f;
#pragma unroll
        for (int j = 0; j < 8; ++j) { v[j] = xr[64 * j]; s += (v[j].x * v[j].x + v[j].y * v[j].y) + (v[j].z * v[j].z + v[j].w * v[j].w); }
        const float r = 1.0f / sqrtf(wave_sum(s) * (1.0f / DM) + RMS_EPS);
        u32x2* o1 = (u32x2*)(d1 + (size_t)m * DM) + lane;
#pragma unroll
        for (int j = 0; j < 8; ++j) { const f32x4 g = ((const f32x4*)g1)[lane + 64 * j]; u32x2 w; w.x = cvtpk(v[j].x * r * g.x, v[j].y * r * g.y); w.y = cvtpk(v[j].z * r * g.z, v[j].w * r * g.w); o1[64 * j] = w; }
        if (d2) { u32x2* o2 = (u32x2*)(d2 + (size_t)m * DM) + lane;
#pragma unroll
            for (int j = 0; j < 8; ++j) { const f32x4 g = ((const f32x4*)g2)[lane + 64 * j]; u32x2 w; w.x = cvtpk(v[j].x * r * g.x, v[j].y * r * g.y); w.y = cvtpk(v[j].z * r * g.z, v[j].w * r * g.w); o2[64 * j] = w; } }
    }
}
__device__ __forceinline__ void cast_rows(const float* src, bf16* d1, float* ssq, int gw, int ngw) {
    const int lane = fresh_tid() & 63;
    for (int m = gw; m < MTOK; m += ngw) {
        const f32x4* xr = (const f32x4*)(src + (size_t)m * DM) + lane;
        f32x4 v[8]; float s = 0.f;
#pragma unroll
        for (int j = 0; j < 8; ++j) { v[j] = xr[64 * j]; s += (v[j].x * v[j].x + v[j].y * v[j].y) + (v[j].z * v[j].z + v[j].w * v[j].w); }
        s = wave_sum(s);
        u32x2* o1 = (u32x2*)(d1 + (size_t)m * DM) + lane;
#pragma unroll
        for (int j = 0; j < 8; ++j) { u32x2 w; w.x = cvtpk(v[j].x, v[j].y); w.y = cvtpk(v[j].z, v[j].w); o1[64 * j] = w; }
        if (lane < 32) ssq[(size_t)m * 32 + lane] = lane == 0 ? s : 0.f;
    }
}
__device__ __forceinline__ void final_norm(float* io, const float* g1, int gw, int ngw) {
    const int lane = fresh_tid() & 63;
    for (int m = gw; m < MTOK; m += ngw) {
        f32x4* xr = (f32x4*)(io + (size_t)m * DM) + lane;
        f32x4 v[8]; float s = 0.f;
#pragma unroll
        for (int j = 0; j < 8; ++j) { v[j] = xr[64 * j]; s += (v[j].x * v[j].x + v[j].y * v[j].y) + (v[j].z * v[j].z + v[j].w * v[j].w); }
        const float r = 1.0f / sqrtf(wave_sum(s) * (1.0f / DM) + RMS_EPS);
#pragma unroll
        for (int j = 0; j < 8; ++j) { const f32x4 g = ((const f32x4*)g1)[lane + 64 * j]; xr[64 * j] = v[j] * r * g; }
    }
}

__device__ __forceinline__ int kperm(int r) { return (r & 0x13) | ((r & 4) << 1) | ((r & 8) >> 1); }
__device__ __forceinline__ int crow(int r, int hi) { return (r & 3) + 8 * (r >> 2) + 4 * hi; }

namespace dattn {
constexpr int NS = 4, STAGE = 32768, KSUB = 8192, VOFF = 16384;
constexpr int LUT_OFF = NS * STAGE;
constexpr int BT_OFF = LUT_OFF + 2048, BT_KMAX = 192, BT_LEN = 336;
constexpr int NUNITS = BATCH * 16 * 64;
#define DA_WAITV(n) asm volatile("s_waitcnt vmcnt(" #n ")" ::: "memory")

__device__ __forceinline__ void unit(int b, int h, int qb, const bf16* __restrict__ Q, const bf16* __restrict__ K, const bf16* __restrict__ VT, bf16* __restrict__ O,
                                     LAS unsigned char* lds, int btsel) {
    int tid_ = threadIdx.x; asm volatile("" : "+v"(tid_));
    const int tid = tid_, lane = tid & 63, r32 = lane & 31, hi = lane >> 5;
    const int wid = __builtin_amdgcn_readfirstlane(tid >> 6), c = wid & 1, rg = wid >> 1;
    const int Q0 = qb * 128, qw = Q0 + 32 * rg, q = qw + r32;
    const int NT = Q0 / 64 + 2;
    const size_t tok0 = (size_t)b * SEQ;
    const LAS float* bt4 = (const LAS float*)(lds + BT_OFF + btsel * (4 * BT_LEN * 4));
    bf16x8 qf[4];
    { const bf16* qp = Q + (tok0 + q) * DM + (2 * h + c) * 64 + 8 * hi;
#pragma unroll
      for (int ks = 0; ks < 4; ++ks) qf[ks] = *(const bf16x8*)(qp + 16 * ks); }
    const int drow = 8 * wid + (lane >> 3), dch = (lane & 7) ^ ((drow >> 1) & 7);
    const int kgo = drow * DM + dch * 8, vgo = drow * 64 + dch * 8;
    const bf16* kgb = K + tok0 * DM + (2 * h) * 64;
    const bf16* vgb = VT + ((size_t)(b * 128) * 2048 + h * 128) * 64;
    const int dpiece = wid * 1024;
#define DA_DMA(t, st) do { const bf16* kb_ = kgb + (size_t)(t) * 64 * DM + kgo; const bf16* vb_ = vgb + (size_t)(t) * 2048 * 64 + vgo; LAS unsigned char* l_ = lds + (st) * STAGE + dpiece; \
        __builtin_amdgcn_global_load_lds((const unsigned*)kb_, (LAS unsigned*)l_, 16, 0, 0); \
        __builtin_amdgcn_global_load_lds((const unsigned*)(kb_ + 64), (LAS unsigned*)(l_ + KSUB), 16, 0, 0); \
        __builtin_amdgcn_global_load_lds((const unsigned*)vb_, (LAS unsigned*)(l_ + VOFF), 16, 0, 0); \
        __builtin_amdgcn_global_load_lds((const unsigned*)(vb_ + 64 * 64), (LAS unsigned*)(l_ + VOFF + 8192), 16, 0, 0); } while (0)
    DA_DMA(0, 0); DA_DMA(1, 1);
#pragma unroll
    for (int ks = 0; ks < 4; ++ks) asm volatile("" : "+v"(qf[ks]));
    f32x16 o[4];
#pragma unroll
    for (int i = 0; i < 4; ++i) o[i] = f32x16{};
    float m = 0.f, l = 0.f; f32x16 negm = f32x16{}; asm volatile("" : "+v"(negm));
    const int kr_ = kperm(r32);
    const int kbase_ = c * KSUB + kr_ * 128, kx16 = (hi ^ ((kr_ >> 1) & 7)) << 4, vbase_ = VOFF + r32 * 128, vx16 = (hi ^ ((r32 >> 1) & 7)) << 4;
#define koffk_(i) (kbase_ + ((32 * (i)) ^ kx16))
#define voffj_(i) (vbase_ + ((32 * (i)) ^ vx16))
    f32x16 pA0 = f32x16{}, pA1 = f32x16{}, pB0, pB1;
#define SBAR() __builtin_amdgcn_sched_barrier(0)
#define LDF(p) (*(const LAS bf16x8*)(p))
#define GA(MF, X, B, W, L, H) do { MF; sacc += X[B]; sacc += X[B + 1]; sacc += X[B + 2]; sacc += X[B + 3]; asm volatile("" : "+v"(sacc)); W.L = cvtpk(X[B], X[B + 1]); W.H = cvtpk(X[B + 2], X[B + 3]); asm volatile("" : "+v"(W)); SBAR(); } while (0)
#define GB(MF, X, B) do { MF; X[B] = __builtin_amdgcn_exp2f(X[B]); X[B + 1] = __builtin_amdgcn_exp2f(X[B + 1]); asm volatile("" : "+v"(X)); SBAR(); } while (0)
#define MF32(a, b, c) __builtin_amdgcn_mfma_f32_32x32x16_bf16(a, b, c, 0, 0, 0)
#define DA_STEP(tt, C0, C1, P0, P1) do { const int t_ = (tt), k0_ = 64 * t_; \
        DA_WAITV(4); __builtin_amdgcn_s_barrier(); \
        { int tn = t_ + 2; tn = tn < NT ? tn : NT - 1; DA_DMA(tn, (t_ + 2) & 3); } \
        const LAS unsigned char* sk_ = lds + (t_ & 3) * STAGE; const LAS unsigned char* sv_ = lds + ((t_ ? t_ - 1 : 0) & 3) * STAGE; \
        bf16x8 kf[8], va[4], vb[4]; u32x4 pw0, pw1, pw2, pw3; \
        _Pragma("unroll") for (int i = 0; i < 8; ++i) kf[i] = LDF(sk_ + koffk_(i & 3) + (i >> 2) * 4096); \
        _Pragma("unroll") for (int db = 0; db < 4; ++db) va[db] = LDF(sv_ + voffj_(0) + db * 4096); \
        SBAR(); float sacc = 0.f; \
        GA(C0 = MF32(kf[0], qf[0], negm), P0, 0, pw0, x, y); \
        GA(C1 = MF32(kf[4], qf[0], negm), P0, 4, pw0, z, w); \
        GA(C0 = MF32(kf[1], qf[1], C0), P0, 8, pw1, x, y); \
        GA(C1 = MF32(kf[5], qf[1], C1), P0, 12, pw1, z, w); \
        GA(C0 = MF32(kf[2], qf[2], C0), P1, 0, pw2, x, y); \
        GA(C1 = MF32(kf[6], qf[2], C1), P1, 4, pw2, z, w); \
        GA(C0 = MF32(kf[3], qf[3], C0), P1, 8, pw3, x, y); \
        GA(C1 = MF32(kf[7], qf[3], C1), P1, 12, pw3, z, w); \
        _Pragma("unroll") for (int db = 0; db < 4; ++db) vb[db] = LDF(sv_ + voffj_(1) + db * 4096); \
        l += sacc; \
        if (qw - (k0_ + 63) < 128) { \
            const int u0_ = (BT_KMAX - 1) - (q - k0_ - 8 * hi);        \
            const LAS float* tb_ = bt4 + (u0_ & 3) * BT_LEN + (u0_ & ~3); \
            _Pragma("unroll") for (int g_ = 0; g_ < 4; ++g_) { const f32x4 b0_ = *(const LAS f32x4*)(tb_ + 16 * g_), b1_ = *(const LAS f32x4*)(tb_ + 16 * g_ + 4); \
                if (g_ < 2) { _Pragma("unroll") for (int i = 0; i < 4; ++i) { C0[8 * g_ + i] += b0_[i]; C0[8 * g_ + 4 + i] += b1_[i]; } } \
                else { _Pragma("unroll") for (int i = 0; i < 4; ++i) { C1[8 * (g_ - 2) + i] += b0_[i]; C1[8 * (g_ - 2) + 4 + i] += b1_[i]; } } } } \
        float mx = C0[0]; \
        _Pragma("unroll") for (int r = 1; r < 16; ++r) mx = fmaxf(mx, C0[r]); \
        _Pragma("unroll") for (int r = 0; r < 16; ++r) mx = fmaxf(mx, C1[r]); \
        mx = fmaxf(mx, swap32(mx)); \
        bool resc = false; float alpha = 1.f; \
        if (t_ == 0 || __any(mx > 8.0f)) {        \
            const float dl = (t_ == 0) ? mx : fmaxf(mx, 0.f); m += dl; alpha = (t_ == 0) ? 1.f : __builtin_amdgcn_exp2f(-dl); resc = (t_ != 0); \
            _Pragma("unroll") for (int r = 0; r < 16; ++r) { C0[r] -= dl; C1[r] -= dl; } \
            _Pragma("unroll") for (int r = 0; r < 16; ++r) negm[r] = -m; asm volatile("" : "+v"(negm)); } \
        SBAR(); \
        const bf16x8 f0 = __builtin_bit_cast(bf16x8, pw0), f1 = __builtin_bit_cast(bf16x8, pw1), f2 = __builtin_bit_cast(bf16x8, pw2), f3 = __builtin_bit_cast(bf16x8, pw3); \
        bf16x8 vc[4], vd[4]; \
        GB(o[0] = MF32(va[0], f0, o[0]), C0, 0); \
        _Pragma("unroll") for (int db = 0; db < 4; ++db) vc[db] = LDF(sv_ + voffj_(2) + db * 4096); \
        GB(o[1] = MF32(va[1], f0, o[1]), C0, 2); GB(o[2] = MF32(va[2], f0, o[2]), C0, 4); GB(o[3] = MF32(va[3], f0, o[3]), C0, 6); \
        GB(o[0] = MF32(vb[0], f1, o[0]), C0, 8); \
        _Pragma("unroll") for (int db = 0; db < 4; ++db) vd[db] = LDF(sv_ + voffj_(3) + db * 4096); \
        GB(o[1] = MF32(vb[1], f1, o[1]), C0, 10); GB(o[2] = MF32(vb[2], f1, o[2]), C0, 12); GB(o[3] = MF32(vb[3], f1, o[3]), C0, 14); \
        GB(o[0] = MF32(vc[0], f2, o[0]), C1, 0); GB(o[1] = MF32(vc[1], f2, o[1]), C1, 2); GB(o[2] = MF32(vc[2], f2, o[2]), C1, 4); GB(o[3] = MF32(vc[3], f2, o[3]), C1, 6); \
        GB(o[0] = MF32(vd[0], f3, o[0]), C1, 8); GB(o[1] = MF32(vd[1], f3, o[1]), C1, 10); GB(o[2] = MF32(vd[2], f3, o[2]), C1, 12); GB(o[3] = MF32(vd[3], f3, o[3]), C1, 14); \
        if (resc) { _Pragma("unroll") for (int i = 0; i < 4; ++i) o[i] *= alpha; l *= alpha; } \
    } while (0)
    for (int t = 0; t < NT; t += 2) {
        DA_STEP(t, pB0, pB1, pA0, pA1);
        DA_STEP(t + 1, pA0, pA1, pB0, pB1);
    }
    {
        const LAS unsigned char* sv_ = lds + ((NT - 1) & 3) * STAGE;
        float sacc = 0.f; u32x4 pw[4];
#pragma unroll
        for (int r = 0; r < 16; ++r) sacc += pA0[r];
#pragma unroll
        for (int r = 0; r < 16; ++r) sacc += pA1[r];
        l += sacc;
#pragma unroll
        for (int j = 0; j < 2; ++j) { pw[j] = (u32x4){cvtpk(pA0[8 * j], pA0[8 * j + 1]), cvtpk(pA0[8 * j + 2], pA0[8 * j + 3]), cvtpk(pA0[8 * j + 4], pA0[8 * j + 5]), cvtpk(pA0[8 * j + 6], pA0[8 * j + 7])};
            pw[2 + j] = (u32x4){cvtpk(pA1[8 * j], pA1[8 * j + 1]), cvtpk(pA1[8 * j + 2], pA1[8 * j + 3]), cvtpk(pA1[8 * j + 4], pA1[8 * j + 5]), cvtpk(pA1[8 * j + 6], pA1[8 * j + 7])}; }
#pragma unroll
        for (int j = 0; j < 4; ++j) { const bf16x8 f = __builtin_bit_cast(bf16x8, pw[j]);
#pragma unroll
            for (int db = 0; db < 4; ++db) o[db] = MF32(LDF(sv_ + voffj_(j) + db * 4096), f, o[db]); }
    }
#undef DA_STEP
#undef GA
#undef GB
#undef MF32
#undef LDF
#undef SBAR
#undef DA_DMA
    DA_WAITV(0);
    __syncthreads();
    l += swap32(l);
    const float inv = 1.0f / l;
    LAS float* comb = (LAS float*)lds;
    if (c == 1) {
#pragma unroll
        for (int db = 0; db < 4; ++db)
#pragma unroll
            for (int r = 0; r < 16; ++r) comb[((rg * 4 + db) * 16 + r) * 64 + lane] = o[db][r] * inv;
    }
    __syncthreads();
    if (c == 0) {
        const float lam_l = ((const LAS float*)(lds + LUT_OFF + 1024))[128];
        float ss = 0.f;
#pragma unroll
        for (int db = 0; db < 4; ++db)
#pragma unroll
            for (int r = 0; r < 16; ++r) { const float y = o[db][r] * inv - lam_l * comb[((rg * 4 + db) * 16 + r) * 64 + lane]; o[db][r] = y; ss += y * y; }
        ss += swap32(ss);
        const float rs = 1.0f / sqrtf(ss * (1.0f / 128.0f) + RMS_EPS);
        bf16* op = O + (tok0 + q) * DM + h * 128 + 4 * hi;
        const LAS float* gl = (const LAS float*)(lds + LUT_OFF + 1024);
#pragma unroll
        for (int db = 0; db < 4; ++db)
#pragma unroll
            for (int j = 0; j < 4; ++j) { const f32x4 g = *(const LAS f32x4*)(gl + 32 * db + 8 * j + 4 * hi);
                u32x2 w; w.x = cvtpk(o[db][4 * j + 0] * rs * g.x, o[db][4 * j + 1] * rs * g.y); w.y = cvtpk(o[db][4 * j + 2] * rs * g.z, o[db][4 * j + 3] * rs * g.w);
                *(u32x2*)(op + 32 * db + 8 * j) = w; }
    }
    __syncthreads();
}
}

namespace sbattn {
constexpr int NUNITS = BATCH * 16 * 256;
__device__ __forceinline__ void unit(int b, int h, int qblk, const bf16* __restrict__ Q, const bf16* __restrict__ K, const bf16* __restrict__ VT, bf16* __restrict__ O, LAS unsigned char* wl) {
    int tid_ = threadIdx.x; asm volatile("" : "+v"(tid_));
    const int lane = tid_ & 63, r32 = lane & 31, hi = lane >> 5;
    const size_t tok0 = (size_t)b * SEQ;
    const int q = qblk * 32 + r32;
    bf16x8 qf[8];
    { const bf16* qp = Q + (tok0 + q) * DM + h * 128 + 8 * hi;
#pragma unroll
      for (int ks = 0; ks < 8; ++ks) qf[ks] = *(const bf16x8*)(qp + 16 * ks);
#pragma unroll
      for (int ks = 0; ks < 8; ++ks) asm volatile("" : "+v"(qf[ks])); }
    f32x16 o[4];
#pragma unroll
    for (int i = 0; i < 4; ++i) o[i] = f32x16{};
    float carry = 0.f;
    const int kkey = lane >> 4, kch = lane & 15, vd = lane >> 2, vch = lane & 3;
    const bf16* kg = K + (tok0 + kkey) * DM + h * 128 + kch * 8;
    const bf16* vg = VT + ((size_t)(b * 128) * 2048 + h * 128 + vd) * 64 + vch * 8;
    const int kr = kperm(r32);
    int kro[8], vro[2];
#pragma unroll
    for (int ks = 0; ks < 8; ++ks) kro[ks] = kr * 256 + (((2 * ks + hi) ^ (kr & 15)) << 4);
#pragma unroll
    for (int s = 0; s < 2; ++s) vro[s] = 8192 + r32 * 64 + (((2 * s + hi) ^ ((r32 >> 2) & 3)) << 4);
    for (int kt = qblk; kt >= 0; --kt) {
        const int k0 = kt * 32;
        u32x4 kraw[8], vraw[8];
        { const bf16* kp = kg + (size_t)k0 * DM; const bf16* vp = vg + (size_t)(k0 >> 6) * 2048 * 64 + (k0 & 63);
#pragma unroll
          for (int i = 0; i < 8; ++i) kraw[i] = *(const u32x4*)(kp + (size_t)(4 * i) * DM);
#pragma unroll
          for (int i = 0; i < 8; ++i) vraw[i] = *(const u32x4*)(vp + (16 * i) * 64); }
#pragma unroll
        for (int i = 0; i < 8; ++i) { const int key = 4 * i + kkey; *(LAS u32x4*)(wl + key * 256 + ((kch ^ (key & 15)) << 4)) = kraw[i]; }
#pragma unroll
        for (int i = 0; i < 8; ++i) { const int d = 16 * i + vd; *(LAS u32x4*)(wl + 8192 + d * 64 + ((vch ^ ((d >> 2) & 3)) << 4)) = vraw[i]; }
        f32x16 z = f32x16{};
        { bf16x8 kf[8];
#pragma unroll
          for (int ks = 0; ks < 8; ++ks) kf[ks] = *(const LAS bf16x8*)(wl + kro[ks]);
#pragma unroll
          for (int ks = 0; ks < 8; ++ks) z = __builtin_amdgcn_mfma_f32_32x32x16_bf16(kf[ks], qf[ks], z, 0, 0, 0); }
        bf16x8 vf[4][2];
#pragma unroll
        for (int db = 0; db < 4; ++db)
#pragma unroll
            for (int s = 0; s < 2; ++s) vf[db][s] = *(const LAS bf16x8*)(wl + vro[s] + db * 32 * 64);
        float L[16], lz[16];
        float A0 = 0.f, A1 = 0.f;
#pragma unroll
        for (int r = 0; r < 16; ++r) {
            const int key = k0 + 16 * (r >> 3) + 8 * hi + (r & 7);
            const float zz = z[r];
            const float sp = fmaxf(zz, 0.f) + LN2 * __builtin_amdgcn_logf(1.0f + __builtin_amdgcn_exp2f(-LOG2E * fabsf(zz)));
            const bool valid = key < q;
            L[r] = valid ? -sp : 0.f;
            lz[r] = valid ? (zz - sp) : -INFINITY;
            if (r < 8) A0 += L[r]; else A1 += L[r];
        }
        const float B0 = swap32(A0), B1 = swap32(A1);
        const float base0 = hi ? (B1 + A1) : (B0 + A1 + B1);
        const float base1 = hi ? 0.f : B1;
        float a[16];
        { float run = base0 + carry;
#pragma unroll
          for (int i = 7; i >= 0; --i) { a[i] = __builtin_amdgcn_exp2f(LOG2E * (lz[i] + run)); run += L[i]; }
          run = base1 + carry;
#pragma unroll
          for (int i = 15; i >= 8; --i) { a[i] = __builtin_amdgcn_exp2f(LOG2E * (lz[i] + run)); run += L[i]; } }
        carry += (A0 + A1) + (B0 + B1);
        bf16x8 pf[2];
#pragma unroll
        for (int s = 0; s < 2; ++s) { u32x4 w; w.x = cvtpk(a[8 * s + 0], a[8 * s + 1]); w.y = cvtpk(a[8 * s + 2], a[8 * s + 3]); w.z = cvtpk(a[8 * s + 4], a[8 * s + 5]); w.w = cvtpk(a[8 * s + 6], a[8 * s + 7]); pf[s] = __builtin_bit_cast(bf16x8, w); }
#pragma unroll
        for (int db = 0; db < 4; ++db)
#pragma unroll
            for (int s = 0; s < 2; ++s) o[db] = __builtin_amdgcn_mfma_f32_32x32x16_bf16(vf[db][s], pf[s], o[db], 0, 0, 0);
        if (__all(carry < -105.0f)) break;
    }
    bf16* op = O + (tok0 + q) * DM + h * 128 + 4 * hi;
#pragma unroll
    for (int db = 0; db < 4; ++db)
#pragma unroll
        for (int j = 0; j < 4; ++j) { u32x2 w; w.x = cvtpk(o[db][4 * j + 0], o[db][4 * j + 1]); w.y = cvtpk(o[db][4 * j + 2], o[db][4 * j + 3]); *(u32x2*)(op + 32 * db + 8 * j) = w; }
}
}

#define XB_TMO      128
#define XB_XCNT(j)  (256  + 64 * (j))
#define XB_XSUB(j)  (1280 + 64 * (j))
#define XB_XGEN(j)  (2304 + 64 * (j))
#define XB_TOP      3328
#define XB_TOPGEN   3392
#define XCD_BAR_WORDS 3456
#define XB_SPIN_CAP (1u << 18)

__device__ __forceinline__ unsigned xb_ld(unsigned* p)              { return __hip_atomic_load(p, __ATOMIC_RELAXED, __HIP_MEMORY_SCOPE_AGENT); }
__device__ __forceinline__ unsigned xb_add(unsigned* p, unsigned v) { return __hip_atomic_fetch_add(p, v, __ATOMIC_RELAXED, __HIP_MEMORY_SCOPE_AGENT); }
__device__ __forceinline__ unsigned xb_xcc_id() { return (unsigned)__builtin_amdgcn_s_getreg((3 << 11) | 20) & 0xFu; }
#define XB_SPIN(cond, bar) do { unsigned _sp = 0; while (cond) { __builtin_amdgcn_s_sleep(1); \
    if ((++_sp & 255u) == 0u) { if (xb_ld(&(bar)[XB_TMO])) break; if (_sp > XB_SPIN_CAP) { atomicAdd(&(bar)[XB_TMO], 1u); break; } } } } while (0)

struct XcdBarrier {
    unsigned* bar; unsigned x;
    volatile LAS unsigned* st;
};

__device__ __forceinline__ XcdBarrier xcd_barrier_post(unsigned* bar, volatile LAS unsigned* st) {
    XcdBarrier b; b.bar = bar; b.x = xb_xcc_id(); b.st = st;
    if (threadIdx.x == 0) (void)xb_add(&bar[XB_XCNT(b.x)], 1u);
    return b;
}
__device__ __forceinline__ void xcd_barrier_complete(unsigned* bar, unsigned x, unsigned& nloc, unsigned& nx) {
    const unsigned G = gridDim.x * gridDim.y * gridDim.z;
    unsigned sum, cnt, mine, sp = 0u;
    for (;;) {
        sum = 0u; cnt = 0u; mine = 0u;
#pragma unroll
        for (unsigned j = 0; j < 16; ++j) { const unsigned c = xb_ld(&bar[XB_XCNT(j)]); sum += c; cnt += (c > 0u) ? 1u : 0u; mine = (j == x) ? c : mine; }
        if (sum == G) break;
        __builtin_amdgcn_s_sleep(1);
        if ((++sp & 255u) == 0u) { if (xb_ld(&bar[XB_TMO])) break; if (sp > XB_SPIN_CAP) { atomicAdd(&bar[XB_TMO], 1u); break; } }
    }
    nloc = mine > 0u ? mine : 1u; nx = cnt > 0u ? cnt : 1u;
}

__device__ __forceinline__ void xcd_barrier(const XcdBarrier& b) {
    asm volatile("s_waitcnt vmcnt(0)" ::: "memory");
    __syncthreads();
    if (threadIdx.x == 0) {
        unsigned* bar = b.bar;
        __builtin_amdgcn_s_waitcnt(0);
        unsigned nloc = b.st[0], nx = b.st[1];
        if (nloc == 0u) { xcd_barrier_complete(bar, b.x, nloc, nx); b.st[0] = nloc; b.st[1] = nx; }
        const unsigned old = xb_add(&bar[XB_XSUB(b.x)], 1u);
        const unsigned gen = old / nloc;
        if (old + 1u == (gen + 1u) * nloc) {
            __builtin_amdgcn_fence(__ATOMIC_RELEASE, "agent");
            asm volatile("s_waitcnt vmcnt(0)" ::: "memory");
            const unsigned og = xb_add(&bar[XB_TOP], 1u);
            const unsigned tg = og / nx;
            if (og + 1u == (tg + 1u) * nx) xb_add(&bar[XB_TOPGEN], 1u);
            else XB_SPIN(xb_ld(&bar[XB_TOPGEN]) == tg, bar);
            __builtin_amdgcn_fence(__ATOMIC_ACQUIRE, "agent");
            xb_add(&bar[XB_XGEN(b.x)], 1u);
            asm volatile("s_waitcnt vmcnt(0)" ::: "memory");
        } else {
            XB_SPIN(xb_ld(&bar[XB_XGEN(b.x)]) == gen, bar);
            __builtin_amdgcn_fence(__ATOMIC_ACQUIRE, "agent");
            asm volatile("s_waitcnt vmcnt(0)" ::: "memory");
        }
    }
    __syncthreads();
}

struct Args {
    const float* x; const float* rel_bias; const float* attn_g; const float* ffn_g; const float* w_qkv; const float* w_o;
    const float* lq1; const float* lk1; const float* lq2; const float* lk2; const float* subln_g; const float* kv_g;
    const float* w_kv; const float* w_sq; const float* w_so; const float* w_gate; const float* w_up; const float* w_down; const float* final_g;
    float* out; unsigned char* ws;
};

__global__ void __launch_bounds__(NTHREADS, 2) yoco_fwd(Args a) {
    extern __shared__ __attribute__((aligned(16))) unsigned char lds_raw[];
    cg::grid_group grid = cg::this_grid();
    LAS unsigned char* lds = (LAS unsigned char*)lds_raw;
    const int wave = __builtin_amdgcn_readfirstlane(threadIdx.x >> 6);
    const int G = gridDim.x, bx = blockIdx.x;
    const int gw = bx * NWAVES + wave, ngw = G * NWAVES;
    unsigned char* ws = a.ws;
    volatile LAS unsigned* xb_st = (volatile LAS unsigned*)(lds + 131072 + 15360);
    if (threadIdx.x < 2) xb_st[threadIdx.x] = 0u;
    __syncthreads();
    const XcdBarrier xbar = xcd_barrier_post((unsigned*)(ws + 4096), xb_st);
    bf16* Wqkv_t = (bf16*)(ws + WS_WQKV); bf16* Wo_t = (bf16*)(ws + WS_WO); bf16* Wkv_t = (bf16*)(ws + WS_WKV); bf16* Wsq_t = (bf16*)(ws + WS_WSQ); bf16* Wso_t = (bf16*)(ws + WS_WSO);
    bf16* Wgu_t = (bf16*)(ws + WS_WGU); bf16* Wd_t = (bf16*)(ws + WS_WD);
    bf16* XN = (bf16*)(ws + WS_XN); bf16* QB = (bf16*)(ws + WS_BIG); bf16* KB = QB + (size_t)MTOK * DM; bf16* VTB = KB + (size_t)MTOK * DM; bf16* MID = QB;
    bf16* KS = (bf16*)(ws + WS_KS); bf16* VTS = (bf16*)(ws + WS_VTS); bf16* XH = (bf16*)(ws + WS_XH);
    LAS float* RT = (LAS float*)(lds + 131072);
    float* SSQ = (float*)(ws + WS_SSQ);

    {
        LAS float* scr = (LAS float*)(lds + wave * 16384);
        const int lane = fresh_tid() & 63;
        constexpr int I_QKV = 32 * 192, I_SQ = 32 * 64, I_KV = 32 * 128, I_G = 32 * 176, I_D = 88 * 64;
        constexpr int NITEMS = 2 * I_QKV + 2 * I_SQ + I_KV + 4 * I_SQ + 4 * (2 * I_G + I_D);
        for (int it = gw; it < NITEMS; it += ngw) {
            int r = it;
            if (r < 2 * I_QKV) { const int l = r / I_QKV; transpose_item(a.w_qkv + (size_t)l * DM * 6144, DM, 6144, Wqkv_t + (size_t)l * 6144 * DM, 0, scr, r % I_QKV, lane, a.attn_g + l * DM); continue; } r -= 2 * I_QKV;
            if (r < 2 * I_SQ) { const int l = r / I_SQ; transpose_item(a.w_o + (size_t)l * DM * DM, DM, DM, Wo_t + (size_t)l * DM * DM, 0, scr, r % I_SQ, lane); continue; } r -= 2 * I_SQ;
            if (r < I_KV) { transpose_item(a.w_kv, DM, 4096, Wkv_t, 0, scr, r, lane, a.kv_g); continue; } r -= I_KV;
            if (r < 2 * I_SQ) { const int l = r / I_SQ; transpose_item(a.w_sq + (size_t)l * DM * DM, DM, DM, Wsq_t + (size_t)l * DM * DM, 0, scr, r % I_SQ, lane, a.attn_g + (2 + l) * DM); continue; } r -= 2 * I_SQ;
            if (r < 2 * I_SQ) { const int l = r / I_SQ; transpose_item(a.w_so + (size_t)l * DM * DM, DM, DM, Wso_t + (size_t)l * DM * DM, 0, scr, r % I_SQ, lane); continue; } r -= 2 * I_SQ;
            if (r < 4 * I_G) { const int l = r / I_G; transpose_item(a.w_gate + (size_t)l * DM * FF, DM, FF, Wgu_t + (size_t)l * 2 * FF * DM, 1, scr, r % I_G, lane, a.ffn_g + l * DM); continue; } r -= 4 * I_G;
            if (r < 4 * I_G) { const int l = r / I_G; transpose_item(a.w_up + (size_t)l * DM * FF, DM, FF, Wgu_t + (size_t)l * 2 * FF * DM, 2, scr, r % I_G, lane, a.ffn_g + l * DM); continue; } r -= 4 * I_G;
            { const int l = r / I_D; transpose_item(a.w_down + (size_t)l * FF * DM, FF, DM, Wd_t + (size_t)l * DM * FF, 0, scr, r % I_D, lane); }
        }
        cast_rows(a.x, XH, SSQ, gw, ngw);
    }
    grid.sync();

    for (int l = 0; l < 4; ++l) {
        const bool diff = l < 2;
        const float* hsrc = (l == 0) ? a.x : a.out;
        const float* ssq_a = SSQ + (size_t)(2 * l) * MTOK * 32;
        float* ssq_f = SSQ + (size_t)(2 * l + 1) * MTOK * 32;
        float* ssq_n = SSQ + (size_t)(2 * l + 2) * MTOK * 32;
        {
            pg8::Gemm g{XH, XH, MTOK, DM, DM};
            pg8::MultiOrder S;
            const bf16* Wp = diff ? Wqkv_t + (size_t)l * 6144 * DM : Wsq_t + (size_t)(l - 2) * DM * DM;
            const bf16* Wv = diff ? Wqkv_t + (size_t)l * 6144 * DM + (size_t)4096 * DM : Wkv_t + (size_t)2048 * DM;
            S.s0.init(MTOK, diff ? 4096 : 2048, G, bx); S.A0 = XH; S.B0 = Wp; S.n0 = pg8::MultiOrder::count(S.s0);
            S.s1.init(DM, MTOK, G, bx); S.A1 = Wv; S.B1 = XH; S.n1 = (diff || l == 2) ? pg8::MultiOrder::count(S.s1) : 0;
            S.s2.init(MTOK, DM, G, bx); S.A2 = XH; S.B2 = Wkv_t; S.n2 = (l == 2) ? pg8::MultiOrder::count(S.s2) : 0;
            pg8::build_rtab<false>(RT, ssq_a, S);
            pg8::EpiMulti E{pg8::EpiBf16{QB, DM, 2048, (size_t)MTOK * DM, diff ? 0.125f * LOG2E : 0.08838834764831845f, RT},
                            pg8::EpiVT{diff ? VTB : VTS, RT},
                            pg8::EpiBf16{KS, DM, 0, 0, 1.f, RT}};
            pg8::gemm_phase<pg8::EpiMulti, pg8::MultiOrder, true, true>(lds, g, S, E);
        }
        xcd_barrier(xbar);
        if (diff) {
            const float lam_init = (l == 0) ? 0.2f : 0.35550906759f;
            float lam;
            const int tid = fresh_tid(), lane = tid & 63;
            { const float p1 = a.lq1[l * 64 + lane] * a.lk1[l * 64 + lane], p2 = a.lq2[l * 64 + lane] * a.lk2[l * 64 + lane];
              lam = expf(wave_sum(p1)) - expf(wave_sum(p2)) + lam_init; }
            for (int e = tid; e < 8 * dattn::BT_LEN; e += NTHREADS) {
                const int p = e / (4 * dattn::BT_LEN), e4 = e - p * 4 * dattn::BT_LEN, c = e4 / dattn::BT_LEN, i = e4 - c * dattn::BT_LEN, k = dattn::BT_KMAX - (i + c);
                const int pos0 = p ? (G + G - 1 - bx) : bx, h = (pos0 % 32) & 15;
                float v = 0.f;
                if (k <= 0) v = -INFINITY;
                else if (k <= 128) { const int n = k - 1; int bucket;
                    if (n < 16) bucket = n; else { int lg = 16 + (int)(logf((float)n / 16.0f) / 2.0794415416798357f * 16.0f); bucket = lg < 31 ? lg : 31; }
                    v = (a.rel_bias[bucket * 16 + h] - a.rel_bias[31 * 16 + h]) * LOG2E; }
                ((LAS float*)(lds + dattn::BT_OFF))[e] = v; }
            if (tid < 128) ((LAS float*)(lds + dattn::LUT_OFF + 1024))[tid] = a.subln_g[l * 128 + tid] * (1.0f - lam_init);
            if (tid == 128) ((LAS float*)(lds + dattn::LUT_OFF + 1024))[128] = lam;
            __syncthreads();
            for (int i = 0;; ++i) {
                const int pos = i * G + ((i & 1) ? (G - 1 - bx) : bx);
                if (pos >= dattn::NUNITS) break;
                const int qb = 63 - pos / 32, bh = pos % 32, b = bh >> 4, h = bh & 15;
                dattn::unit(b, h, qb, QB, KB, VTB, XN, lds, i & 1);
            }
        } else {
            for (int u = gw; u < sbattn::NUNITS; u += ngw) {
                const int bh = u >> 8, qblk = u & 255;
                sbattn::unit(bh >> 4, bh & 15, qblk, QB, KS, VTS, XN, lds + wave * 16384);
            }
        }
        xcd_barrier(xbar);
        {
            pg8::Gemm g{XN, diff ? Wo_t + (size_t)l * DM * DM : Wso_t + (size_t)(l - 2) * DM * DM, MTOK, DM, DM};
            pg8::StaticOrder S; S.init(g.M, g.N, G, bx);
            pg8::EpiResN E{hsrc, a.out, DM, XH, ssq_f};
            pg8::gemm_phase<pg8::EpiResN, pg8::StaticOrder, true, true>(lds, g, S, E);
        }
        xcd_barrier(xbar);
        {
            pg8::Gemm g{XH, Wgu_t + (size_t)l * 2 * FF * DM, MTOK, 2 * FF, DM};
            pg8::StaticOrder S; S.init(g.M, g.N, G, bx);
            pg8::build_rtab<false>(RT, ssq_f, S);
            pg8::EpiSwiGLU E{MID, FF, RT};
            pg8::gemm_phase<pg8::EpiSwiGLU, pg8::StaticOrder, true, true>(lds, g, S, E);
        }
        xcd_barrier(xbar);
        {
            pg8::Gemm g{MID, Wd_t + (size_t)l * DM * FF, MTOK, DM, FF};
            pg8::StaticOrder S; S.init(g.M, g.N, G, bx);
            pg8::EpiResN E{a.out, a.out, DM, l < 3 ? XH : nullptr, ssq_n};
            pg8::gemm_phase<pg8::EpiResN, pg8::StaticOrder, true, true>(lds, g, S, E);
        }
        xcd_barrier(xbar);
    }
    final_norm(a.out, a.final_g, gw, ngw);
}

extern "C" void kernel_launch(void* const* d_in, const int* in_sizes, int n_in, void* d_out, int out_size, void* d_ws, size_t ws_size, hipStream_t stream) {
    static int grid = 0;
    if (grid == 0) {
        if (n_in != 19 || ws_size < WS_END) { fprintf(stderr, "kernel_launch: unexpected inputs (%d) or workspace (%zu < %zu)\n", n_in, ws_size, (size_t)WS_END); grid = -1; return; }
        int dev = 0, cus = 0, per_cu = 0;
        hipGetDevice(&dev); hipDeviceGetAttribute(&cus, hipDeviceAttributeMultiprocessorCount, dev);
        hipFuncSetAttribute((const void*)yoco_fwd, hipFuncAttributeMaxDynamicSharedMemorySize, LDS_BYTES);
        hipOccupancyMaxActiveBlocksPerMultiprocessor(&per_cu, (const void*)yoco_fwd, NTHREADS, LDS_BYTES);
        (void)hipGetLastError();
        if (per_cu < 1) per_cu = 1;
        grid = cus * per_cu;
    }
    if (grid < 0) return;
    Args a{};
    a.x = (const float*)d_in[0]; a.rel_bias = (const float*)d_in[1]; a.attn_g = (const float*)d_in[2]; a.ffn_g = (const float*)d_in[3]; a.w_qkv = (const float*)d_in[4]; a.w_o = (const float*)d_in[5];
    a.lq1 = (const float*)d_in[6]; a.lk1 = (const float*)d_in[7]; a.lq2 = (const float*)d_in[8]; a.lk2 = (const float*)d_in[9]; a.subln_g = (const float*)d_in[10]; a.kv_g = (const float*)d_in[11];
    a.w_kv = (const float*)d_in[12]; a.w_sq = (const float*)d_in[13]; a.w_so = (const float*)d_in[14]; a.w_gate = (const float*)d_in[15]; a.w_up = (const float*)d_in[16]; a.w_down = (const float*)d_in[17]; a.final_g = (const float*)d_in[18];
    a.out = (float*)d_out; a.ws = (unsigned char*)d_ws;
    hipMemsetAsync((char*)d_ws + 4096, 0, XCD_BAR_WORDS * 4, stream);
    void* args[] = {&a};
    hipError_t e = hipLaunchCooperativeKernel((const void*)yoco_fwd, dim3(grid), dim3(NTHREADS), args, LDS_BYTES, stream);
    if (e != hipSuccess) fprintf(stderr, "cooperative launch failed: %s (grid %d)\n", hipGetErrorString(e), grid);
}
```
